# Optimizing an MI355X kernel written in HIP

```python
import math
import jax, jax.numpy as jnp
from jax import lax
import numpy as np

D_MODEL = 1024
BATCH = 2
SEQ = 8192
DEPTH = 1

PLE_DIM = 256
EPS = 1e-6
GLA_HEADS = 4
GLA_DK = D_MODEL // 2 // GLA_HEADS
GLA_DV = D_MODEL // GLA_HEADS
GLA_RANK = 16
GLA_TAU = 16.0
GLA_CHUNK = 64
GLA_QK_W = GLA_HEADS * GLA_DK
GLA_V_W = GLA_HEADS * GLA_DV
ATT_GROUPS = ((128, 1), (512, 4), (2048, 16))
ATT_HEADS_PER_GROUP = 4
ATT_HEAD_DIM = 128
N_ATT_GROUPS = len(ATT_GROUPS)
N_ATT_HEADS = N_ATT_GROUPS * ATT_HEADS_PER_GROUP
ATT_W = ATT_HEADS_PER_GROUP * ATT_HEAD_DIM
ATT_BLOCK = 128
REL_BUCKETS = 32
REL_MAX_DIST = 2048
D_FF = 4 * D_MODEL
NEG_INF = -1e30

SPLIT_SIZES = (GLA_QK_W, GLA_QK_W, GLA_V_W, GLA_V_W, GLA_RANK,
               N_ATT_GROUPS * 3 * ATT_W, 2 * D_MODEL)
IN_COLS = sum(SPLIT_SIZES)

kernel_name = "hybrid_gla_dilated_attn_gated_block"


def rmsnorm(x, g):
    xf = x.astype(jnp.float32)
    y = xf * lax.rsqrt(jnp.mean(xf * xf, axis=-1, keepdims=True) + EPS)
    return (y * g.astype(jnp.float32)).astype(x.dtype)


def _split_cols(h, sizes):
    offsets = np.cumsum(np.array(sizes))[:-1].tolist()
    return jnp.split(h, offsets, axis=-1)


def _t5_causal_bucket(n):
    max_exact = REL_BUCKETS // 2
    nf = np.maximum(n, 1).astype(np.float32)
    large = max_exact + (np.log(nf / max_exact) / np.log(REL_MAX_DIST / max_exact)
                         * (REL_BUCKETS - max_exact)).astype(np.int32)
    large = np.minimum(large, REL_BUCKETS - 1)
    return np.where(n < max_exact, n, large).astype(np.int32)


def _group_bias(rel_bias, g, dil):
    qi = np.arange(ATT_BLOCK)[:, None]
    kj = np.arange(2 * ATT_BLOCK)[None, :]
    dist = np.maximum(qi + ATT_BLOCK - kj, 0) * dil
    bucket = _t5_causal_bucket(dist)
    tab = rel_bias[:, g * ATT_HEADS_PER_GROUP:(g + 1) * ATT_HEADS_PER_GROUP]
    return jnp.transpose(tab[bucket], (2, 0, 1)).astype(jnp.float32)


def gla_mixer(q, k, v, log_a):
    B, S, H, dk = q.shape
    dv = v.shape[-1]
    C = GLA_CHUNK
    N = S // C

    def chunk(t):
        return t.astype(jnp.float32).reshape(B, N, C, H, t.shape[-1]).transpose(0, 3, 1, 2, 4)

    q, k, v, g = chunk(q), chunk(k), chunk(v), chunk(log_a)
    b = jnp.cumsum(g, axis=3)
    b_last = b[:, :, :, -1:, :]
    q_dec = q * (dk ** -0.5) * jnp.exp(b)
    k_in = k * jnp.exp(-b)
    k_out = k * jnp.exp(b_last - b)
    causal = np.tril(np.ones((C, C), dtype=bool))
    attn = jnp.where(causal, jnp.einsum('bhncd,bhnsd->bhncs', q_dec, k_in), 0.0)
    o_intra = jnp.einsum('bhncs,bhnsv->bhncv', attn, v)
    upd = jnp.einsum('bhncd,bhncv->nbhdv', k_out, v)
    decay = jnp.exp(b_last[:, :, :, 0, :]).transpose(2, 0, 1, 3)

    def step(state, inp):
        dec, u = inp
        return dec[..., None] * state + u, state

    _, states = lax.scan(step, jnp.zeros((B, H, dk, dv), jnp.float32), (decay, upd))
    o_inter = jnp.einsum('bhncd,nbhdv->bhncv', q_dec, states)
    return (o_intra + o_inter).transpose(0, 2, 3, 1, 4).reshape(B, S, H, dv)


def dilated_attention(q, k, v, bias, dil, win_steps):
    B, S, H, hd = q.shape
    BLK = ATT_BLOCK
    L = S // dil
    nb = -(-L // BLK)
    Lp = nb * BLK
    Z = B * dil

    def sub(t):
        return t.reshape(B, L, dil, H, hd).transpose(0, 2, 3, 1, 4).reshape(Z, H, L, hd)

    qs = jnp.pad(sub(q), ((0, 0), (0, 0), (0, Lp - L), (0, 0))).reshape(Z, H, nb, BLK, hd)

    def kv_blocks(t):
        t = jnp.pad(sub(t), ((0, 0), (0, 0), (BLK, Lp - L), (0, 0))).reshape(Z, H, nb + 1, BLK, hd)
        return jnp.concatenate([t[:, :, :-1], t[:, :, 1:]], axis=3)

    kb, vb = kv_blocks(k), kv_blocks(v)
    qi = np.arange(BLK)[:, None]
    kj = np.arange(2 * BLK)[None, :]
    delta = qi + BLK - kj
    band = (delta >= 0) & (delta <= win_steps)
    valid = band[None] & ((np.arange(nb)[:, None, None] > 0) | (kj >= BLK)[None])
    logits = jnp.einsum('zhnqd,zhnkd->zhnqk', qs, kb).astype(jnp.float32) * (hd ** -0.5)
    logits = jnp.where(valid, logits + bias[:, None], NEG_INF)
    m = jnp.max(logits, axis=-1, keepdims=True)
    pexp = jnp.exp(logits - m)
    s = jnp.sum(pexp, axis=-1, keepdims=True)
    o = jnp.einsum('zhnqk,zhnkd->zhnqd', pexp, vb.astype(jnp.float32)) / s
    lse = (m + jnp.log(s))[..., 0]
    o = o.reshape(B, dil, H, Lp, hd)[:, :, :, :L].transpose(0, 3, 1, 2, 4).reshape(B, S, H, hd)
    lse = lse.reshape(B, dil, H, Lp)[..., :L].transpose(0, 3, 1, 2).reshape(B, S, H)
    return o, lse


def setup_inputs(seed: int = 0) -> dict:
    key = jax.random.key(seed)
    ks = jax.random.split(key, 20)

    def nrm(k, shape, scale):
        return jax.random.normal(k, shape, jnp.float32) * scale

    return {
        "x": nrm(ks[0], (BATCH, SEQ, D_MODEL), 1.0),
        "p": nrm(ks[1], (DEPTH, BATCH, SEQ, PLE_DIM), 1.0),
        "ln1": 1.0 + nrm(ks[2], (DEPTH, D_MODEL), 0.02),
        "w_in": nrm(ks[3], (DEPTH, D_MODEL, IN_COLS), D_MODEL ** -0.5),
        "w_a2": nrm(ks[4], (DEPTH, GLA_RANK, GLA_QK_W), GLA_RANK ** -0.5),
        "b_a": nrm(ks[5], (DEPTH, GLA_QK_W), 0.1),
        "gla_gn": 1.0 + nrm(ks[6], (DEPTH, GLA_V_W), 0.02),
        "w_o_gla": nrm(ks[7], (DEPTH, GLA_V_W, D_MODEL), GLA_V_W ** -0.5),
        "w_o_attn": nrm(ks[8], (DEPTH, ATT_W, D_MODEL), ATT_W ** -0.5),
        "w_out": nrm(ks[9], (DEPTH, D_MODEL, D_MODEL), D_MODEL ** -0.5),
        "ln2": 1.0 + nrm(ks[10], (DEPTH, D_MODEL), 0.02),
        "w_mlp1": nrm(ks[11], (DEPTH, D_MODEL, D_FF), D_MODEL ** -0.5),
        "w_mlp2": nrm(ks[12], (DEPTH, D_FF, D_MODEL), D_FF ** -0.5),
        "ln3": 1.0 + nrm(ks[13], (DEPTH, D_MODEL), 0.02),
        "w_pp": nrm(ks[14], (DEPTH, PLE_DIM, D_MODEL), PLE_DIM ** -0.5),
        "w_pg": nrm(ks[15], (DEPTH, D_MODEL, D_MODEL), D_MODEL ** -0.5),
        "rel_bias": nrm(ks[16], (REL_BUCKETS, N_ATT_HEADS), 0.5),
        "ln_f": 1.0 + nrm(ks[17], (D_MODEL,), 0.02),
    }


def reference(x, p, ln1, w_in, w_a2, b_a, gla_gn, w_o_gla, w_o_attn, w_out,
              ln2, w_mlp1, w_mlp2, ln3, w_pp, w_pg, rel_bias, ln_f):
    B, S, _ = x.shape
    for i in range(DEPTH):
        h = rmsnorm(x, ln1[i])
        hq, hk, hv, hr, ha, hatt, hgate = _split_cols(h @ w_in[i], SPLIT_SIZES)

        log_a = jax.nn.log_sigmoid((ha @ w_a2[i] + b_a[i]).astype(jnp.float32)) / GLA_TAU
        o = gla_mixer(hq.reshape(B, S, GLA_HEADS, GLA_DK),
                      hk.reshape(B, S, GLA_HEADS, GLA_DK),
                      hv.reshape(B, S, GLA_HEADS, GLA_DV),
                      log_a.reshape(B, S, GLA_HEADS, GLA_DK))
        o = o * lax.rsqrt(jnp.mean(o * o, axis=-1, keepdims=True) + EPS)
        o = o.reshape(B, S, GLA_V_W) * gla_gn[i].astype(jnp.float32) * jax.nn.silu(hr.astype(jnp.float32))
        y_gla = o.astype(x.dtype) @ w_o_gla[i]

        hatt = hatt.reshape(B, S, N_ATT_GROUPS, 3, ATT_HEADS_PER_GROUP, ATT_HEAD_DIM)
        outs, lses = [], []
        for g, (win, dil) in enumerate(ATT_GROUPS):
            o_g, lse_g = dilated_attention(hatt[:, :, g, 0], hatt[:, :, g, 1], hatt[:, :, g, 2],
                                           _group_bias(rel_bias, g, dil), dil, win // dil)
            outs.append(o_g)
            lses.append(lse_g)
        wts = jax.nn.softmax(jnp.stack(lses, axis=0), axis=0)
        o_att = jnp.sum(wts[..., None] * jnp.stack(outs, axis=0), axis=0).reshape(B, S, ATT_W)
        y_att = o_att.astype(x.dtype) @ w_o_attn[i]

        g_gla, g_att = jnp.split(hgate, 2, axis=-1)
        mix = (jax.nn.sigmoid(g_gla) * y_gla + jax.nn.sigmoid(g_att) * y_att) @ w_out[i]
        x = x + mix

        h2 = rmsnorm(x, ln2[i])
        x = x + jnp.square(jax.nn.relu(h2 @ w_mlp1[i])) @ w_mlp2[i]

        h3 = rmsnorm(x, ln3[i])
        x = x + jax.nn.sigmoid(h3 @ w_pg[i]) * (p[i] @ w_pp[i])
    return rmsnorm(x, ln_f)
```

```cpp
#include <hip/hip_runtime.h>
#include <cstdint>
#include <cstdio>

typedef unsigned short bf16;
typedef float f32x4 __attribute__((ext_vector_type(4)));
typedef unsigned u32x4 __attribute__((ext_vector_type(4)));

constexpr int BATCH = 2, SEQ = 8192, D = 1024, M = BATCH * SEQ, FF = 4096, PLE = 256;
constexpr int IN_COLS = 9744;
constexpr int C_Q = 0, C_K = 512, C_V = 1024, C_R = 2048, C_A = 3072, C_ATT = 3088, C_GATE = 7696;
constexpr int N_ATT = 4608, N_GLA = 3072, N_GATE = 2048;
constexpr int NCHUNK = M / 64;
constexpr float EPS = 1e-6f;

constexpr size_t MiB = 1u << 20;
constexpr size_t WS_CTL = 0;
constexpr size_t WS_WATT = 1 * MiB, WS_WGLA = 10 * MiB, WS_WGATE = 16 * MiB, WS_WOGLA = 20 * MiB, WS_WOATT = 22 * MiB, WS_WOUT = 23 * MiB;
constexpr size_t WS_W1 = 25 * MiB, WS_W2 = 33 * MiB, WS_WPG = 41 * MiB, WS_WPP = 43 * MiB;
constexpr size_t WS_DEC = 43 * MiB + 512 * 1024;
constexpr size_t WS_RS2 = 44 * MiB;
constexpr size_t WS_RS3 = 44 * MiB + 256 * 1024;
constexpr size_t WS_LUT = 44 * MiB + 512 * 1024;
constexpr size_t WS_XCH = 45 * MiB;
constexpr size_t WS_XN = 46 * MiB;
constexpr size_t WS_PB = 78 * MiB;
constexpr size_t WS_R = 86 * MiB;
constexpr size_t WS_QKVA = WS_R;
constexpr size_t WS_QD = WS_R, WS_KI = WS_R + 16 * MiB, WS_KO = WS_R + 32 * MiB, WS_V = WS_R + 48 * MiB, WS_RG = WS_R + 80 * MiB, WS_US = WS_R + 112 * MiB;
constexpr size_t WS_SG = WS_R, WS_UF = WS_R + 64 * MiB, WS_U = WS_R + 128 * MiB;
constexpr size_t WS_X1B = WS_R, WS_H = WS_R + 32 * MiB;
constexpr size_t WS_SGP = WS_R + 32 * MiB;
constexpr size_t WS_END = 256 * MiB;
constexpr size_t DO_BC = 0, DO_OGLA = 0, DO_OATT = 40 * MiB;

__device__ __forceinline__ float bf2f(bf16 v) { return __uint_as_float((unsigned)v << 16); }
__device__ __forceinline__ bf16 f2bf(float f) { unsigned u = __float_as_uint(f); return (bf16)((u + 0x7fffu + ((u >> 16) & 1u)) >> 16); }
__device__ __forceinline__ float wave_sum(float v) {
#pragma unroll
    for (int o = 1; o < 64; o <<= 1) v += __shfl_xor(v, o);
    return v;
}
__device__ __forceinline__ float sigmoidf_(float x) { return 1.f / (1.f + __expf(-x)); }

__global__ void k_wconv(const float* __restrict__ W, int ldw, int col0, int K, int N, const float* __restrict__ sc, bf16* __restrict__ dst) {
    const size_t total = (size_t)K * N;
    for (size_t i = (size_t)blockIdx.x * blockDim.x + threadIdx.x; i < total; i += (size_t)gridDim.x * blockDim.x) {
        const int k = (int)(i / N), n = (int)(i % N);
        float v = W[(size_t)k * ldw + col0 + n]; if (sc) v *= sc[k];
        dst[(size_t)n * K + k] = f2bf(v);
    }
}
__global__ void k_pconv(const float* __restrict__ p, bf16* __restrict__ pb, size_t n) {
    for (size_t i = (size_t)blockIdx.x * blockDim.x + threadIdx.x; i < n; i += (size_t)gridDim.x * blockDim.x) pb[i] = f2bf(p[i]);
}
__global__ void k_lut(const float* __restrict__ rel_bias, float* __restrict__ lut) {
    const int i = blockIdx.x * blockDim.x + threadIdx.x; if (i >= 3 * 4 * 129) return;
    const int g = i / (4 * 129), hh = (i / 129) % 4, dl = i % 129;
    const int dil = g == 0 ? 1 : (g == 1 ? 4 : 16); const int n = dl * dil;
    int bucket;
    if (n < 16) bucket = n; else { int l = 16 + (int)(log((double)n / 16.0) / log(128.0) * 16.0); bucket = l < 31 ? l : 31; }
    lut[i] = rel_bias[bucket * 12 + g * 4 + hh];
}
__global__ void __launch_bounds__(512) k_p0chunk(const float* __restrict__ x, const float* __restrict__ ln1, const float* __restrict__ w_in,
                                                  const float* __restrict__ w_a2, const float* __restrict__ b_a, bf16* __restrict__ XN, float* __restrict__ BC, float* __restrict__ DEC) {
    __shared__ float ha[64][16];
    const int tid = threadIdx.x, lane = tid & 63, wave = tid >> 6, chunk = blockIdx.x;
    for (int rr = 0; rr < 8; ++rr) {
        const int r = wave * 8 + rr; const size_t row = (size_t)chunk * 64 + r;
        float ss = 0.f;
#pragma unroll
        for (int j = 0; j < 4; ++j) { const f32x4 v = *(const f32x4*)(x + row * D + 256 * j + 4 * lane); ss += v[0] * v[0] + v[1] * v[1] + v[2] * v[2] + v[3] * v[3]; }
        ss = wave_sum(ss); const float rstd = rsqrtf(ss * (1.f / D) + EPS);
        float acc[16];
#pragma unroll
        for (int o = 0; o < 16; ++o) acc[o] = 0.f;
#pragma unroll 1
        for (int j = 0; j < 4; ++j) {
            const int c0 = 256 * j + 4 * lane;
            const f32x4 v = *(const f32x4*)(x + row * D + c0); const f32x4 g = *(const f32x4*)(ln1 + c0);
            float h[4];
#pragma unroll
            for (int e = 0; e < 4; ++e) { h[e] = v[e] * rstd * g[e];
                const float* wr = w_in + (size_t)(c0 + e) * IN_COLS + C_A;
#pragma unroll
                for (int o = 0; o < 16; ++o) acc[o] += h[e] * wr[o]; }
            *(uint2*)(XN + row * D + c0) = make_uint2((unsigned)f2bf(h[0]) | ((unsigned)f2bf(h[1]) << 16), (unsigned)f2bf(h[2]) | ((unsigned)f2bf(h[3]) << 16));
        }
#pragma unroll
        for (int o = 0; o < 16; ++o) { const float s = wave_sum(acc[o]); if (lane == 0) ha[r][o] = s; }
    }
    __syncthreads();
    {
        const int t = tid; float w[16];
#pragma unroll
        for (int j = 0; j < 16; ++j) w[j] = w_a2[j * 512 + t];
        const float bb = b_a[t]; float cum = 0.f;
        for (int r = 0; r < 64; ++r) {
            float z = bb;
#pragma unroll
            for (int j = 0; j < 16; ++j) z += ha[r][j] * w[j];
            const float ls = fminf(z, 0.f) - log1pf(expf(-fabsf(z)));
            cum += ls * (1.f / 16.f);
            BC[((size_t)chunk * 64 + r) * 512 + t] = cum;
        }
        DEC[(size_t)chunk * 512 + t] = expf(cum);
    }
}

template <class Epi>
__global__ void __launch_bounds__(256) k_gemm(const bf16* __restrict__ A, int lda, const bf16* __restrict__ Bt, int ldb, int K, Epi epi) {
    const int tx = threadIdx.x & 15, ty = threadIdx.x >> 4;
    const int r0 = blockIdx.y * 64 + ty * 4, c0 = blockIdx.x * 64 + tx * 4;
    float acc[4][4];
#pragma unroll
    for (int i = 0; i < 4; ++i)
#pragma unroll
        for (int j = 0; j < 4; ++j) acc[i][j] = 0.f;
    for (int k = 0; k < K; k += 8) {
        u32x4 a[4], b[4];
#pragma unroll
        for (int i = 0; i < 4; ++i) { a[i] = *(const u32x4*)(A + (size_t)(r0 + i) * lda + k); b[i] = *(const u32x4*)(Bt + (size_t)(c0 + i) * ldb + k); }
#pragma unroll
        for (int e = 0; e < 4; ++e) {
            float al[4], ah[4], bl[4], bh[4];
#pragma unroll
            for (int i = 0; i < 4; ++i) { al[i] = __uint_as_float(a[i][e] << 16); ah[i] = __uint_as_float(a[i][e] & 0xffff0000u); bl[i] = __uint_as_float(b[i][e] << 16); bh[i] = __uint_as_float(b[i][e] & 0xffff0000u); }
#pragma unroll
            for (int i = 0; i < 4; ++i)
#pragma unroll
                for (int j = 0; j < 4; ++j) acc[i][j] += al[i] * bl[j] + ah[i] * bh[j];
        }
    }
#pragma unroll
    for (int i = 0; i < 4; ++i)
#pragma unroll
        for (int j = 0; j < 4; ++j) epi(r0 + i, c0 + j, acc[i][j]);
}
struct EAtt { bf16* O; __device__ void operator()(int r, int c, float v) const { O[(size_t)r * N_ATT + c] = f2bf(v); } };
struct EGla { bf16 *QD, *KI, *KO, *V, *R; const float* BC;
    __device__ void operator()(int r, int c, float v) const {
        if (c < 512) { QD[(size_t)r * 512 + c] = f2bf(v * 0.08838834764831845f * __expf(BC[(size_t)r * 512 + c])); }
        else if (c < 1024) { const int cc = c - 512; const float b = BC[(size_t)r * 512 + cc], bl = BC[(size_t)(r | 63) * 512 + cc];
            KI[(size_t)r * 512 + cc] = f2bf(v * __expf(-b)); KO[(size_t)r * 512 + cc] = f2bf(v * __expf(bl - b)); }
        else if (c < 2048) V[(size_t)r * 1024 + c - 1024] = f2bf(v);
        else R[(size_t)r * 1024 + c - 2048] = f2bf(v);
    } };
struct EGate { bf16* SG; __device__ void operator()(int r, int c, float v) const { SG[(size_t)(c >> 10) * M * 1024 + (size_t)r * 1024 + (c & 1023)] = f2bf(sigmoidf_(v)); } };
struct EY1 { const bf16* SG; float* UF; __device__ void operator()(int r, int c, float v) const { UF[(size_t)r * 1024 + c] = bf2f(SG[(size_t)r * 1024 + c]) * v; } };
struct EY2 { const bf16* SG; const float* UF; bf16* U; __device__ void operator()(int r, int c, float v) const { U[(size_t)r * 1024 + c] = f2bf(UF[(size_t)r * 1024 + c] + bf2f(SG[(size_t)M * 1024 + (size_t)r * 1024 + c]) * v); } };
struct EOut { const float* x; float* x1; bf16* X1B; __device__ void operator()(int r, int c, float v) const { const float o = x[(size_t)r * 1024 + c] + v; x1[(size_t)r * 1024 + c] = o; X1B[(size_t)r * 1024 + c] = f2bf(o); } };
struct EMlp1 { const float* RS; bf16* H; __device__ void operator()(int r, int c, float v) const {
        const float ss = RS[r * 4] + RS[r * 4 + 1] + RS[r * 4 + 2] + RS[r * 4 + 3]; const float rstd = rsqrtf(ss * (1.f / D) + EPS);
        const float t = fmaxf(v * rstd, 0.f); H[(size_t)r * FF + c] = f2bf(t * t); } };
struct EMlp2 { float* x; bf16* X2B; __device__ void operator()(int r, int c, float v) const { const float o = x[(size_t)r * 1024 + c] + v; x[(size_t)r * 1024 + c] = o; X2B[(size_t)r * 1024 + c] = f2bf(o); } };
struct EPg { const float* RS; float* SGP; __device__ void operator()(int r, int c, float v) const {
        const float ss = RS[r * 4] + RS[r * 4 + 1] + RS[r * 4 + 2] + RS[r * 4 + 3]; const float rstd = rsqrtf(ss * (1.f / D) + EPS);
        SGP[(size_t)r * 1024 + c] = sigmoidf_(v * rstd); } };
struct EPp { const float* SGP; float* x; __device__ void operator()(int r, int c, float v) const { x[(size_t)r * 1024 + c] += SGP[(size_t)r * 1024 + c] * v; } };

__global__ void __launch_bounds__(256) k_rowsq(const float* __restrict__ x, float* __restrict__ RS) {
    const int lane = threadIdx.x & 63; const int row = blockIdx.x * 4 + (threadIdx.x >> 6);
    float ss = 0.f;
#pragma unroll
    for (int j = 0; j < 4; ++j) { const f32x4 v = *(const f32x4*)(x + (size_t)row * D + 256 * j + 4 * lane); ss += v[0] * v[0] + v[1] * v[1] + v[2] * v[2] + v[3] * v[3]; }
    ss = wave_sum(ss);
    if (lane < 4) RS[row * 4 + lane] = lane == 0 ? ss : 0.f;
}
__global__ void __launch_bounds__(256) k_final(float* __restrict__ x, const float* __restrict__ lnf) {
    const int lane = threadIdx.x & 63; const int row = blockIdx.x * 4 + (threadIdx.x >> 6);
    f32x4 v[4]; float ss = 0.f;
#pragma unroll
    for (int j = 0; j < 4; ++j) { v[j] = *(const f32x4*)(x + (size_t)row * D + 256 * j + 4 * lane); ss += v[j][0] * v[j][0] + v[j][1] * v[j][1] + v[j][2] * v[j][2] + v[j][3] * v[j][3]; }
    ss = wave_sum(ss); const float rstd = rsqrtf(ss * (1.f / D) + EPS);
#pragma unroll
    for (int j = 0; j < 4; ++j) { const f32x4 g = *(const f32x4*)(lnf + 256 * j + 4 * lane); *(f32x4*)(x + (size_t)row * D + 256 * j + 4 * lane) = v[j] * rstd * g; }
}

__global__ void __launch_bounds__(256) k_attn(const bf16* __restrict__ QKV, const float* __restrict__ LUT, bf16* __restrict__ OATT) {
    __shared__ float P[4][3 * 129 + 1];
    const int lane = threadIdx.x & 63, w = threadIdx.x >> 6;
    const int task = blockIdx.x * 4 + w; const int row = task >> 2, hh = task & 3;
    const int b = row / SEQ, t = row % SEQ;
    float lg[3][3]; float mx = -1e30f;
#pragma unroll
    for (int g = 0; g < 3; ++g) {
        const int dil = g == 0 ? 1 : (g == 1 ? 4 : 16);
        const bf16* q = QKV + (size_t)row * N_ATT + g * 1536 + hh * 128;
        u32x4 qv[16];
#pragma unroll
        for (int i = 0; i < 16; ++i) qv[i] = *(const u32x4*)(q + 8 * i);
#pragma unroll
        for (int rd = 0; rd < 3; ++rd) {
            const int dl = lane + 64 * rd; float v = -1e30f;
            if (dl <= 128 && t - dl * dil >= 0) {
                const bf16* k = QKV + (size_t)(b * SEQ + t - dl * dil) * N_ATT + g * 1536 + 512 + hh * 128;
                float s = 0.f;
#pragma unroll
                for (int i = 0; i < 16; ++i) { const u32x4 kv = *(const u32x4*)(k + 8 * i);
#pragma unroll
                    for (int e = 0; e < 4; ++e) s += __uint_as_float(qv[i][e] << 16) * __uint_as_float(kv[e] << 16) + __uint_as_float(qv[i][e] & 0xffff0000u) * __uint_as_float(kv[e] & 0xffff0000u); }
                v = s * 0.08838834764831845f + LUT[(g * 4 + hh) * 129 + dl];
            }
            lg[g][rd] = v; mx = fmaxf(mx, v);
        }
    }
#pragma unroll
    for (int o = 1; o < 64; o <<= 1) mx = fmaxf(mx, __shfl_xor(mx, o));
    float sum = 0.f;
#pragma unroll
    for (int g = 0; g < 3; ++g)
#pragma unroll
        for (int rd = 0; rd < 3; ++rd) { const int dl = lane + 64 * rd; const float p = lg[g][rd] > -1e29f ? __expf(lg[g][rd] - mx) : 0.f; sum += p; if (dl <= 128) P[w][g * 129 + dl] = p; }
    sum = wave_sum(sum);
    __syncthreads();
    float o0 = 0.f, o1 = 0.f;
    for (int g = 0; g < 3; ++g) {
        const int dil = g == 0 ? 1 : (g == 1 ? 4 : 16);
        for (int dl = 0; dl <= 128; ++dl) {
            if (t - dl * dil < 0) break;
            const float p = P[w][g * 129 + dl];
            const unsigned vv = *(const unsigned*)(QKV + (size_t)(b * SEQ + t - dl * dil) * N_ATT + g * 1536 + 1024 + hh * 128 + 2 * lane);
            o0 += p * __uint_as_float(vv << 16); o1 += p * __uint_as_float(vv & 0xffff0000u);
        }
    }
    const float inv = 1.f / sum;
    *(unsigned*)(OATT + (size_t)row * 512 + hh * 128 + 2 * lane) = (unsigned)f2bf(o0 * inv) | ((unsigned)f2bf(o1 * inv) << 16);
}

__global__ void __launch_bounds__(256) k_gla(const bf16* __restrict__ QD, const bf16* __restrict__ KI, const bf16* __restrict__ KO, const bf16* __restrict__ V,
                                             const bf16* __restrict__ R, const float* __restrict__ DEC, const float* __restrict__ gn, bf16* __restrict__ OGLA) {
    __shared__ float sq[64][129], sko[64][129], att[64][65], red[64][4];
    __shared__ float ski[64][129];
    const int tid = threadIdx.x, b = blockIdx.x >> 2, h = blockIdx.x & 3;
    float S[128];
#pragma unroll
    for (int d = 0; d < 128; ++d) S[d] = 0.f;
    for (int n = 0; n < 128; ++n) {
        const size_t row0 = (size_t)b * SEQ + n * 64;
        __syncthreads();
        for (int i = tid; i < 64 * 128; i += 256) { const int c = i >> 7, d = i & 127; const size_t o = (row0 + c) * 512 + h * 128 + d; sq[c][d] = bf2f(QD[o]); ski[c][d] = bf2f(KI[o]); sko[c][d] = bf2f(KO[o]); }
        __syncthreads();
        for (int i = tid; i < 64 * 64; i += 256) { const int c = i >> 6, s = i & 63; float a = 0.f; if (s <= c) { for (int d = 0; d < 128; ++d) a += sq[c][d] * ski[s][d]; } att[c][s] = a; }
        __syncthreads();
        float vcol[64];
#pragma unroll
        for (int s = 0; s < 64; ++s) vcol[s] = bf2f(V[(row0 + s) * 1024 + h * 256 + tid]);
        const float g = gn[h * 256 + tid];
        for (int c = 0; c < 64; ++c) {
            float o = 0.f;
#pragma unroll
            for (int d = 0; d < 128; ++d) o += sq[c][d] * S[d];
#pragma unroll
            for (int s = 0; s < 64; ++s) o += att[c][s] * vcol[s];
            const float ss = wave_sum(o * o);
            __syncthreads();
            if ((tid & 63) == 0) red[c][tid >> 6] = ss;
            __syncthreads();
            const float tot = red[c][0] + red[c][1] + red[c][2] + red[c][3];
            const float rstd = rsqrtf(tot * (1.f / 256.f) + EPS);
            const float r = bf2f(R[(row0 + c) * 1024 + h * 256 + tid]);
            const float silu = r / (1.f + __expf(-r));
            OGLA[(row0 + c) * 1024 + h * 256 + tid] = f2bf(o * rstd * g * silu);
        }
        const float* dec = DEC + (size_t)(b * 128 + n) * 512 + h * 128;
#pragma unroll
        for (int d = 0; d < 128; ++d) { float u = 0.f;
#pragma unroll
            for (int s = 0; s < 64; ++s) u += sko[s][d] * vcol[s];
            S[d] = dec[d] * S[d] + u; }
    }
}

extern "C" void kernel_launch(void* const* d_in, const int* in_sizes, int n_in, void* d_out, int out_size, void* d_ws, size_t ws_size, hipStream_t stream) {
    if (n_in != 18 || ws_size < WS_END || out_size != M * D) { fprintf(stderr, "kernel_launch: unexpected shapes (n_in %d ws %zu out %d)\n", n_in, ws_size, out_size); return; }
    const float* x = (const float*)d_in[0]; const float* p = (const float*)d_in[1]; const float* ln1 = (const float*)d_in[2]; const float* w_in = (const float*)d_in[3];
    const float* w_a2 = (const float*)d_in[4]; const float* b_a = (const float*)d_in[5]; const float* gla_gn = (const float*)d_in[6]; const float* w_o_gla = (const float*)d_in[7];
    const float* w_o_attn = (const float*)d_in[8]; const float* w_out = (const float*)d_in[9]; const float* ln2 = (const float*)d_in[10]; const float* w_mlp1 = (const float*)d_in[11];
    const float* w_mlp2 = (const float*)d_in[12]; const float* ln3 = (const float*)d_in[13]; const float* w_pp = (const float*)d_in[14]; const float* w_pg = (const float*)d_in[15];
    const float* rel_bias = (const float*)d_in[16]; const float* ln_f = (const float*)d_in[17];
    char* ws = (char*)d_ws; char* dob = (char*)d_out; float* out = (float*)d_out;
    bf16* WATT = (bf16*)(ws + WS_WATT); bf16* WGLA = (bf16*)(ws + WS_WGLA); bf16* WGATE = (bf16*)(ws + WS_WGATE); bf16* WOGLA = (bf16*)(ws + WS_WOGLA); bf16* WOATT = (bf16*)(ws + WS_WOATT);
    bf16* WOUT = (bf16*)(ws + WS_WOUT); bf16* W1 = (bf16*)(ws + WS_W1); bf16* W2 = (bf16*)(ws + WS_W2); bf16* WPG = (bf16*)(ws + WS_WPG); bf16* WPP = (bf16*)(ws + WS_WPP);
    float* DEC = (float*)(ws + WS_DEC); float* RS2 = (float*)(ws + WS_RS2); float* RS3 = (float*)(ws + WS_RS3); float* LUT = (float*)(ws + WS_LUT);
    bf16* XN = (bf16*)(ws + WS_XN); bf16* PB = (bf16*)(ws + WS_PB);
    float* BC = (float*)(dob + DO_BC); bf16* OGLA = (bf16*)(dob + DO_OGLA); bf16* OATT = (bf16*)(dob + DO_OATT);
    k_wconv<<<2048, 256, 0, stream>>>(w_in, IN_COLS, C_ATT, D, N_ATT, nullptr, WATT);
    k_wconv<<<2048, 256, 0, stream>>>(w_in, IN_COLS, C_Q, D, N_GLA, nullptr, WGLA);
    k_wconv<<<2048, 256, 0, stream>>>(w_in, IN_COLS, C_GATE, D, N_GATE, nullptr, WGATE);
    k_wconv<<<2048, 256, 0, stream>>>(w_o_gla, D, 0, D, D, nullptr, WOGLA);
    k_wconv<<<2048, 256, 0, stream>>>(w_o_attn, D, 0, 512, D, nullptr, WOATT);
    k_wconv<<<2048, 256, 0, stream>>>(w_out, D, 0, D, D, nullptr, WOUT);
    k_wconv<<<2048, 256, 0, stream>>>(w_mlp1, FF, 0, D, FF, ln2, W1);
    k_wconv<<<2048, 256, 0, stream>>>(w_mlp2, D, 0, FF, D, nullptr, W2);
    k_wconv<<<2048, 256, 0, stream>>>(w_pg, D, 0, D, D, ln3, WPG);
    k_wconv<<<2048, 256, 0, stream>>>(w_pp, D, 0, PLE, D, nullptr, WPP);
    k_pconv<<<2048, 256, 0, stream>>>(p, PB, (size_t)M * PLE);
    k_lut<<<(3 * 4 * 129 + 255) / 256, 256, 0, stream>>>(rel_bias, LUT);
    k_p0chunk<<<NCHUNK, 512, 0, stream>>>(x, ln1, w_in, w_a2, b_a, XN, BC, DEC);
    k_gemm<EAtt><<<dim3(N_ATT / 64, M / 64), 256, 0, stream>>>(XN, D, WATT, D, D, EAtt{(bf16*)(ws + WS_QKVA)});
    k_attn<<<M * 4 / 4, 256, 0, stream>>>((const bf16*)(ws + WS_QKVA), LUT, OATT);
    k_gemm<EGla><<<dim3(N_GLA / 64, M / 64), 256, 0, stream>>>(XN, D, WGLA, D, D, EGla{(bf16*)(ws + WS_QD), (bf16*)(ws + WS_KI), (bf16*)(ws + WS_KO), (bf16*)(ws + WS_V), (bf16*)(ws + WS_RG), BC});
    k_gla<<<8, 256, 0, stream>>>((const bf16*)(ws + WS_QD), (const bf16*)(ws + WS_KI), (const bf16*)(ws + WS_KO), (const bf16*)(ws + WS_V), (const bf16*)(ws + WS_RG), DEC, gla_gn, OGLA);
    k_gemm<EGate><<<dim3(N_GATE / 64, M / 64), 256, 0, stream>>>(XN, D, WGATE, D, D, EGate{(bf16*)(ws + WS_SG)});
    k_gemm<EY1><<<dim3(D / 64, M / 64), 256, 0, stream>>>(OGLA, D, WOGLA, D, D, EY1{(const bf16*)(ws + WS_SG), (float*)(ws + WS_UF)});
    k_gemm<EY2><<<dim3(D / 64, M / 64), 256, 0, stream>>>(OATT, 512, WOATT, 512, 512, EY2{(const bf16*)(ws + WS_SG), (const float*)(ws + WS_UF), (bf16*)(ws + WS_U)});
    k_gemm<EOut><<<dim3(D / 64, M / 64), 256, 0, stream>>>((const bf16*)(ws + WS_U), D, WOUT, D, D, EOut{x, out, (bf16*)(ws + WS_X1B)});
    k_rowsq<<<M / 4, 256, 0, stream>>>(out, RS2);
    k_gemm<EMlp1><<<dim3(FF / 64, M / 64), 256, 0, stream>>>((const bf16*)(ws + WS_X1B), D, W1, D, D, EMlp1{RS2, (bf16*)(ws + WS_H)});
    k_gemm<EMlp2><<<dim3(D / 64, M / 64), 256, 0, stream>>>((const bf16*)(ws + WS_H), FF, W2, FF, FF, EMlp2{out, (bf16*)(ws + WS_X1B)});
    k_rowsq<<<M / 4, 256, 0, stream>>>(out, RS3);
    k_gemm<EPg><<<dim3(D / 64, M / 64), 256, 0, stream>>>((const bf16*)(ws + WS_X1B), D, WPG, D, D, EPg{RS3, (float*)(ws + WS_SGP)});
    k_gemm<EPp><<<dim3(D / 64, M / 64), 256, 0, stream>>>(PB, PLE, WPP, PLE, PLE, EPp{(const float*)(ws + WS_SGP), out});
    k_final<<<M / 4, 256, 0, stream>>>(out, ln_f);
}
```

```cpp
#include <hip/hip_runtime.h>
#include <cstdint>
#include <cstdio>
namespace pg8 {
#define PG8_LAS __attribute__((address_space(3)))
typedef unsigned short bf16_t;
typedef short bf16x8 __attribute__((ext_vector_type(8)));
typedef float f32x4 __attribute__((ext_vector_type(4)));
typedef unsigned u32x4 __attribute__((ext_vector_type(4)));
constexpr int BM = 256, BK = 64, HALF = 128, HTB = HALF * BK * 2  , STAGE_BYTES = 8 * HTB, NXCD = 8, WGM = 8;

__host__ __device__ __forceinline__ int lds_byte(int r, int c) { const int st = (r >> 4) * 2 + (c >> 5), rr = r & 15, cc = c & 31, ob = rr * 64 + cc * 2; return st * 1024 + (ob ^ (((ob >> 9) & 1) << 5)); }
__host__ __device__ __forceinline__ void stage_rc(int b, int& R, int& C) { const int st = b / 1024, sb = b % 1024, swz = sb ^ (((sb >> 9) & 1) << 5); R = (st >> 1) * 16 + swz / 64; C = (st & 1) * 32 + (swz % 64) / 2; }
__host__ __device__ __forceinline__ int perm32(int rho) { const int n = rho >> 4, i = rho & 15; return 8 * (i >> 2) + 4 * n + (i & 3); }

struct Unit { int pm, pn; };
struct Gemm { const bf16_t* A; const bf16_t* Bt; int M, N, K; };

struct StaticOrder {
    int nM, nN, nwg, G, c;
    __host__ __device__ void init(int M, int N, int G_, int c_) { nM = M / BM; nN = N / BM; nwg = nM * nN; G = G_; c = c_; }
    __host__ __device__ bool next(int i, Unit& u) const {
        const long L = (long)i * G + c; if (L >= nwg) return false;
        int wgid = (int)L; { const int q = nwg / NXCD, r = nwg % NXCD, xcd = wgid % NXCD, off = wgid / NXCD; wgid = (xcd < r ? xcd * (q + 1) : r * (q + 1) + (xcd - r) * q) + off; }
        const int nig = WGM * nN, gid = wgid / nig, fm = gid * WGM, gsz = (nM - fm) < WGM ? (nM - fm) : WGM;
        u.pm = fm + ((wgid % nig) % gsz); u.pn = (wgid % nig) / gsz; return true;
    }
    __device__ __forceinline__ void a_ready(const Unit&) const {}
    __device__ __forceinline__ void done(const Unit&) const {}
};

__device__ __forceinline__ unsigned cvt_pk_bf16(float lo, float hi) { unsigned r; asm volatile("v_cvt_pk_bf16_f32 %0, %1, %2" : "=v"(r) : "v"(lo), "v"(hi)); return r; }
typedef float f32x2 __attribute__((ext_vector_type(2)));
template <class Epi, class Sched, bool ALIGN_EPI = false, bool SP2 = false>
__device__ __forceinline__ void gemm_phase(PG8_LAS unsigned char* lds, const Gemm g, const Sched& S, const Epi& E) {
    const int tid = threadIdx.x, wid = __builtin_amdgcn_readfirstlane(tid >> 6), lane = tid & 63, wr = wid >> 2, wc = wid & 3, fr = lane & 15, fq = lane >> 4;
    const int K = g.K, nt = K / BK;
    unsigned voffA[2], voffB[2];
#pragma unroll
    for (int i = 0; i < 2; ++i) { int R, C; stage_rc(tid * 16 + i * 8192, R, C); const int Rb = Epi::PERM ? ((R & ~31) + perm32(R & 31)) : R;
        voffA[i] = (unsigned)(R * K + C) * 2u; voffB[i] = (unsigned)(Rb * K + C) * 2u; }
    const size_t kstep = (size_t)(BK * 2);
    const size_t hstep = (size_t)HALF * K * 2;
    const size_t tstep = 2 * hstep;
    const unsigned ldsw = (unsigned)wid * 1024u;
    const int aoff = lds_byte(wr * 64 + fr, fq * 8), boff = lds_byte(wc * 32 + fr, fq * 8);
#define PG8_SA(b, h) (((b) * 2 + (h)) * HTB)
#define PG8_SB(b, h) ((4 + (b) * 2 + (h)) * HTB)
#define PG8_STAGE(bufoff, gbase, voff) do { _Pragma("unroll") for (int _i = 0; _i < 2; ++_i) \
        __builtin_amdgcn_global_load_lds((const unsigned*)((const char*)(gbase) + (voff)[_i]), (PG8_LAS unsigned*)(lds + (bufoff) + ldsw + _i * 8192), 16, 0, 0); } while (0)
#define PG8_LDA(dst, b, h) do { _Pragma("unroll") for (int m = 0; m < 4; ++m) _Pragma("unroll") for (int k = 0; k < 2; ++k) dst[m][k] = *(const PG8_LAS bf16x8*)(lds + PG8_SA(b, h) + aoff + m * 2048 + k * 1024); } while (0)
#define PG8_LDB(dst, b, h) do { _Pragma("unroll") for (int n = 0; n < 2; ++n) _Pragma("unroll") for (int k = 0; k < 2; ++k) dst[n][k] = *(const PG8_LAS bf16x8*)(lds + PG8_SB(b, h) + boff + n * 2048 + k * 1024); } while (0)
#define PG8_MMA(ai, bj, At, Bt) do { __builtin_amdgcn_s_setprio(1); _Pragma("unroll") for (int m = 0; m < 4; ++m) _Pragma("unroll") for (int n = 0; n < 2; ++n) _Pragma("unroll") for (int k = 0; k < 2; ++k) \
        acc[ai][bj][m][n] = __builtin_amdgcn_mfma_f32_16x16x32_bf16(Bt[n][k], At[m][k], acc[ai][bj][m][n], 0, 0, 0); __builtin_amdgcn_s_setprio(0); } while (0)
#define PG8_WAIT_V(n) asm volatile("s_waitcnt vmcnt(" #n ")" ::: "memory")
#define PG8_WAIT_L(n) asm volatile("s_waitcnt lgkmcnt(" #n ")" ::: "memory")
#define PG8_BAR __builtin_amdgcn_s_barrier()
#define PG8_SCHED __builtin_amdgcn_sched_barrier(0)
    Unit cur, nxt; int ui = 0;
    if (!S.next(0, cur)) return;
    f32x4 acc[2][2][4][2];
#pragma unroll
    for (int a = 0; a < 2; ++a)
#pragma unroll
        for (int b = 0; b < 2; ++b)
#pragma unroll
            for (int m = 0; m < 4; ++m)
#pragma unroll
                for (int n = 0; n < 2; ++n) acc[a][b][m][n] = (f32x4){0.f, 0.f, 0.f, 0.f};
    bf16x8 At[4][2], B0[2][2], B1[2][2];
    const char* cA = (const char*)g.A + (size_t)cur.pm * tstep; const char* cB = (const char*)g.Bt + (size_t)cur.pn * tstep;
    S.a_ready(cur);
    if constexpr (SP2) {
        PG8_STAGE(PG8_SB(0, 0), cB, voffB); PG8_STAGE(PG8_SB(0, 1), cB + hstep, voffB); PG8_STAGE(PG8_SA(0, 0), cA, voffA); PG8_STAGE(PG8_SA(0, 1), cA + hstep, voffA);
        if (wr == 1) PG8_BAR;
        PG8_WAIT_V(2); PG8_BAR;
        PG8_STAGE(PG8_SB(1, 0), cB + kstep, voffB); PG8_STAGE(PG8_SA(1, 0), cA + kstep, voffA); PG8_STAGE(PG8_SB(1, 1), cB + hstep + kstep, voffB);
        PG8_WAIT_V(6); PG8_BAR;
    } else {
        PG8_STAGE(PG8_SB(0, 0), cB, voffB); PG8_STAGE(PG8_SA(0, 0), cA, voffA); PG8_STAGE(PG8_SB(0, 1), cB + hstep, voffB); PG8_STAGE(PG8_SA(0, 1), cA + hstep, voffA);
        if (wr == 1) PG8_BAR;
        PG8_WAIT_V(4); PG8_BAR;
        PG8_STAGE(PG8_SB(1, 0), cB + kstep, voffB); PG8_STAGE(PG8_SA(1, 0), cA + kstep, voffA); PG8_STAGE(PG8_SB(1, 1), cB + hstep + kstep, voffB);
        PG8_WAIT_V(6); PG8_BAR;
    }
    for (;;) {
        const bool has_next = S.next(ui + 1, nxt);
        const char* nA = has_next ? (const char*)g.A + (size_t)nxt.pm * tstep : cA; const char* nB = has_next ? (const char*)g.Bt + (size_t)nxt.pn * tstep : cB;
        for (int t = 0; t < nt; t += 2) {
            const bool last = (t == nt - 2);
            const char* a1 = cA + (size_t)(t + 1) * kstep;
            const char* a2 = last ? nA : cA + (size_t)(t + 2) * kstep; const char* b2 = last ? nB : cB + (size_t)(t + 2) * kstep;
            const char* a3 = a2 + kstep; const char* b3 = b2 + kstep;
            if (last && has_next) S.a_ready(nxt);
            if constexpr (SP2) {
            PG8_LDB(B0, 0, 0); PG8_LDB(B1, 0, 1); PG8_SCHED; PG8_LDA(At, 0, 0); PG8_STAGE(PG8_SA(1, 1), a1 + hstep, voffA);
            PG8_WAIT_V(8); PG8_WAIT_L(0); PG8_BAR; PG8_MMA(0, 0, At, B0); PG8_MMA(0, 1, At, B1); PG8_BAR; PG8_SCHED;
            PG8_LDA(At, 0, 1); PG8_STAGE(PG8_SB(0, 0), b2, voffB); PG8_STAGE(PG8_SB(0, 1), b2 + hstep, voffB); PG8_STAGE(PG8_SA(0, 0), a2, voffA);
            PG8_WAIT_V(8); PG8_WAIT_L(0); PG8_BAR; PG8_MMA(1, 0, At, B0); PG8_MMA(1, 1, At, B1); PG8_BAR; PG8_SCHED;
            PG8_LDB(B0, 1, 0); PG8_LDB(B1, 1, 1); PG8_SCHED; PG8_LDA(At, 1, 0); PG8_STAGE(PG8_SA(0, 1), a2 + hstep, voffA);
            PG8_WAIT_V(8); PG8_WAIT_L(0); PG8_BAR; PG8_MMA(0, 0, At, B0); PG8_MMA(0, 1, At, B1); PG8_BAR; PG8_SCHED;
            PG8_LDA(At, 1, 1); PG8_STAGE(PG8_SB(1, 0), b3, voffB); PG8_STAGE(PG8_SB(1, 1), b3 + hstep, voffB); PG8_STAGE(PG8_SA(1, 0), a3, voffA);
            PG8_WAIT_V(8); PG8_WAIT_L(0); PG8_BAR; PG8_MMA(1, 0, At, B0); PG8_MMA(1, 1, At, B1); PG8_BAR; PG8_SCHED;
            } else {
            PG8_LDB(B0, 0, 0); PG8_SCHED; PG8_LDA(At, 0, 0); PG8_STAGE(PG8_SA(1, 1), a1 + hstep, voffA);
            PG8_WAIT_L(8); PG8_BAR; PG8_WAIT_L(0); PG8_MMA(0, 0, At, B0); PG8_BAR; PG8_SCHED;
            PG8_LDB(B1, 0, 1); PG8_STAGE(PG8_SB(0, 0), b2, voffB);
            PG8_BAR; PG8_WAIT_L(0); PG8_MMA(0, 1, At, B1); PG8_BAR;
            PG8_LDA(At, 0, 1); PG8_STAGE(PG8_SA(0, 0), a2, voffA);
            PG8_BAR; PG8_WAIT_L(0); PG8_MMA(1, 0, At, B0); PG8_BAR; PG8_SCHED;
            PG8_STAGE(PG8_SB(0, 1), b2 + hstep, voffB);
            PG8_WAIT_V(6); PG8_BAR; PG8_MMA(1, 1, At, B1); PG8_BAR;
            PG8_LDB(B0, 1, 0); PG8_SCHED; PG8_LDA(At, 1, 0); PG8_STAGE(PG8_SA(0, 1), a2 + hstep, voffA);
            PG8_WAIT_L(8); PG8_BAR; PG8_WAIT_L(0); PG8_MMA(0, 0, At, B0); PG8_BAR; PG8_SCHED;
            PG8_LDB(B1, 1, 1); PG8_STAGE(PG8_SB(1, 0), b3, voffB);
            PG8_BAR; PG8_WAIT_L(0); PG8_MMA(0, 1, At, B1); PG8_BAR;
            PG8_LDA(At, 1, 1); PG8_STAGE(PG8_SA(1, 0), a3, voffA);
            PG8_BAR; PG8_WAIT_L(0); PG8_MMA(1, 0, At, B0); PG8_BAR; PG8_SCHED;
            PG8_STAGE(PG8_SB(1, 1), b3 + hstep, voffB);
            PG8_WAIT_V(6); PG8_BAR; PG8_MMA(1, 1, At, B1); PG8_BAR;
            }
        }
        if constexpr (ALIGN_EPI) { if (wr == 0) PG8_BAR; }
        if constexpr (!Epi::AFTER_DRAIN) { E(acc, cur, wr, wc, fr, fq); S.done(cur); }
        if (!has_next) break;
#pragma unroll
        for (int a = 0; a < 2; ++a)
#pragma unroll
            for (int b = 0; b < 2; ++b)
#pragma unroll
                for (int m = 0; m < 4; ++m)
#pragma unroll
                    for (int n = 0; n < 2; ++n) acc[a][b][m][n] = (f32x4){0.f, 0.f, 0.f, 0.f};
        cur = nxt; cA = nA; cB = nB; ++ui;
        if constexpr (ALIGN_EPI) { if (wr == 1) PG8_BAR; }
    }
    PG8_WAIT_V(0);
    if constexpr (!ALIGN_EPI) { if (wr == 0) PG8_BAR; }
    PG8_BAR;
    if constexpr (Epi::AFTER_DRAIN) { E.fused(acc, cur, wr, wc, fr, fq, lds, wid, lane); S.done(cur); }
#undef PG8_SA
#undef PG8_SB
#undef PG8_STAGE
#undef PG8_LDA
#undef PG8_LDB
#undef PG8_MMA
#undef PG8_WAIT_V
#undef PG8_WAIT_L
#undef PG8_BAR
#undef PG8_SCHED
}
}
#define GAS __attribute__((address_space(1)))
#define LAS __attribute__((address_space(3)))
typedef unsigned short bf16;
typedef unsigned v4u __attribute__((ext_vector_type(4)));
typedef float f32x4 __attribute__((ext_vector_type(4)));
typedef short bf16x8 __attribute__((ext_vector_type(8)));
typedef GAS unsigned gu32;
typedef GAS unsigned long long gu64;
#define RLX_AGENT __ATOMIC_RELAXED, __HIP_MEMORY_SCOPE_AGENT
#define LDS_WAIT() asm volatile("s_waitcnt lgkmcnt(0)" ::: "memory")
#define VM_WAIT() asm volatile("s_waitcnt vmcnt(0)" ::: "memory")
__device__ __forceinline__ unsigned long long rt() { return __builtin_amdgcn_s_memrealtime(); }
__device__ __forceinline__ unsigned f2bf(float f) { unsigned u = __builtin_bit_cast(unsigned, f); return (u + 0x7fffu + ((u >> 16) & 1u)) >> 16; }
__device__ __forceinline__ unsigned pk2(float lo, float hi) { return f2bf(lo) | (f2bf(hi) << 16); }
#define XB_TMO      128
#define XB_XCNT(j)  (256  + 64 * (j))
#define XB_XSUB(j)  (1280 + 64 * (j))
#define XB_XGEN(j)  (2304 + 64 * (j))
#define XB_TOP      3328
#define XB_TOPGEN   3392
#define XCD_BAR_WORDS 3456
#define XB_SPIN_CAP (1u << 18)

__device__ __forceinline__ unsigned xb_ld(unsigned* p)              { return __hip_atomic_load(p, __ATOMIC_RELAXED, __HIP_MEMORY_SCOPE_AGENT); }
__device__ __forceinline__ unsigned xb_add(unsigned* p, unsigned v) { return __hip_atomic_fetch_add(p, v, __ATOMIC_RELAXED, __HIP_MEMORY_SCOPE_AGENT); }
__device__ __forceinline__ unsigned xb_xcc_id() { return (unsigned)__builtin_amdgcn_s_getreg((3 << 11) | 20) & 0xFu; }
#define XB_SPIN(cond, bar) do { unsigned _sp = 0; while (cond) { __builtin_amdgcn_s_sleep(1); \
    if ((++_sp & 255u) == 0u) { if (xb_ld(&(bar)[XB_TMO])) break; if (_sp > XB_SPIN_CAP) { atomicAdd(&(bar)[XB_TMO], 1u); break; } } } } while (0)

struct XcdBarrier {
    unsigned* bar; unsigned x;
    volatile LAS unsigned* st;
};

__device__ __forceinline__ XcdBarrier xcd_barrier_post(unsigned* bar, volatile LAS unsigned* st) {
    XcdBarrier b; b.bar = bar; b.x = xb_xcc_id(); b.st = st;
    if (threadIdx.x == 0) (void)xb_add(&bar[XB_XCNT(b.x)], 1u);
    return b;
}
__device__ __forceinline__ void xcd_barrier_complete(unsigned* bar, unsigned x, unsigned& nloc, unsigned& nx) {
    const unsigned G = gridDim.x * gridDim.y * gridDim.z;
    unsigned sum, cnt, mine, sp = 0u;
    for (;;) {
        sum = 0u; cnt = 0u; mine = 0u;
#pragma unroll
        for (unsigned j = 0; j < 16; ++j) { const unsigned c = xb_ld(&bar[XB_XCNT(j)]); sum += c; cnt += (c > 0u) ? 1u : 0u; mine = (j == x) ? c : mine; }
        if (sum == G) break;
        __builtin_amdgcn_s_sleep(1);
        if ((++sp & 255u) == 0u) { if (xb_ld(&bar[XB_TMO])) break; if (sp > XB_SPIN_CAP) { atomicAdd(&bar[XB_TMO], 1u); break; } }
    }
    nloc = mine > 0u ? mine : 1u; nx = cnt > 0u ? cnt : 1u;
}

__device__ __forceinline__ void xcd_barrier(const XcdBarrier& b) {
    asm volatile("s_waitcnt vmcnt(0)" ::: "memory");
    __syncthreads();
    if (threadIdx.x == 0) {
        unsigned* bar = b.bar;
        __builtin_amdgcn_s_waitcnt(0);
        unsigned nloc = b.st[0], nx = b.st[1];
        if (nloc == 0u) { xcd_barrier_complete(bar, b.x, nloc, nx); b.st[0] = nloc; b.st[1] = nx; }
        const unsigned old = xb_add(&bar[XB_XSUB(b.x)], 1u);
        const unsigned gen = old / nloc;
        if (old + 1u == (gen + 1u) * nloc) {
            __builtin_amdgcn_fence(__ATOMIC_RELEASE, "agent");
            asm volatile("s_waitcnt vmcnt(0)" ::: "memory");
            const unsigned og = xb_add(&bar[XB_TOP], 1u);
            const unsigned tg = og / nx;
            if (og + 1u == (tg + 1u) * nx) xb_add(&bar[XB_TOPGEN], 1u);
            else XB_SPIN(xb_ld(&bar[XB_TOPGEN]) == tg, bar);
            __builtin_amdgcn_fence(__ATOMIC_ACQUIRE, "agent");
            xb_add(&bar[XB_XGEN(b.x)], 1u);
            asm volatile("s_waitcnt vmcnt(0)" ::: "memory");
        } else {
            XB_SPIN(xb_ld(&bar[XB_XGEN(b.x)]) == gen, bar);
            __builtin_amdgcn_fence(__ATOMIC_ACQUIRE, "agent");
            asm volatile("s_waitcnt vmcnt(0)" ::: "memory");
        }
    }
    __syncthreads();
}
constexpr int BATCH = 2, SEQ = 8192, D = 1024, M = BATCH * SEQ, FF = 4096, PLE = 256;
constexpr int IN_COLS = 9744;
constexpr int C_Q = 0, C_K = 512, C_V = 1024, C_R = 2048, C_A = 3072, C_ATT = 3088, C_GATE = 7696;
constexpr int N_ATT = 4608, N_GLA = 3072, N_GATE = 2048;
constexpr int NCHUNK = M / 64;
constexpr float EPS = 1e-6f;
constexpr float QSCALE = 0.08838834764831845f;
constexpr int NWAVES = 8;

constexpr size_t MiB = 1u << 20;
constexpr size_t WS_CTL = 0, CTL_ZERO_BYTES = 1 * MiB;
constexpr size_t WS_WATT = 1 * MiB, WS_WGLA = 10 * MiB, WS_WGATE = 16 * MiB, WS_WOGLA = 20 * MiB, WS_WOATT = 22 * MiB, WS_WOUT = 23 * MiB;
constexpr size_t WS_W1 = 25 * MiB, WS_W2 = 33 * MiB, WS_WPG = 41 * MiB, WS_WPP = 43 * MiB;
constexpr size_t WS_DEC = 43 * MiB + 512 * 1024;
constexpr size_t WS_RS2 = 44 * MiB;
constexpr size_t WS_RS3 = 45 * MiB;
constexpr size_t WS_LUT = 46 * MiB;
constexpr size_t WS_XN = 47 * MiB;
constexpr size_t WS_PB = 79 * MiB;
constexpr size_t WS_R = 87 * MiB;
constexpr size_t WS_QKVA = WS_R;
constexpr size_t WS_QD = WS_R, WS_KI = WS_R + 16 * MiB, WS_KO = WS_R + 32 * MiB, WS_V = WS_R + 48 * MiB, WS_RG = WS_R + 80 * MiB, WS_US = WS_R + 112 * MiB;
constexpr size_t WS_SG = WS_R, WS_UF = WS_R + 64 * MiB, WS_U = WS_R + 128 * MiB;
constexpr size_t WS_X1B = WS_R, WS_H = WS_R + 32 * MiB;
constexpr size_t WS_END = 256 * MiB;
constexpr size_t DO_BC = 0, DO_OGLA = 0, DO_OATT = 40 * MiB;
constexpr int CW_BAR = 4096;

constexpr int RING_OFF = 0, RING_BYTES = 131072;
constexpr int LDSCTL_OFF = 150 * 1024, MISC_OFF = LDSCTL_OFF + 320;
constexpr int LDS_BYTES = 151 * 1024;
namespace epi {
using pg8::f32x4; using pg8::u32x4; using pg8::Unit; using pg8::cvt_pk_bf16; using pg8::bf16_t;
constexpr int BM = 256, HALF = 128;
__device__ __forceinline__ u32x4 pack8(const f32x4& a, const f32x4& b) { u32x4 w; w.x = cvt_pk_bf16(a[0], a[1]); w.y = cvt_pk_bf16(a[2], a[3]); w.z = cvt_pk_bf16(b[0], b[1]); w.w = cvt_pk_bf16(b[2], b[3]); return w; }
__device__ __forceinline__ void unpack8(const u32x4& w, f32x4& a, f32x4& b) {
    a = (f32x4){__uint_as_float(w.x << 16), __uint_as_float(w.x & 0xffff0000u), __uint_as_float(w.y << 16), __uint_as_float(w.y & 0xffff0000u)};
    b = (f32x4){__uint_as_float(w.z << 16), __uint_as_float(w.z & 0xffff0000u), __uint_as_float(w.w << 16), __uint_as_float(w.w & 0xffff0000u)}; }
__device__ __forceinline__ f32x4 exp4(const f32x4& x) { return (f32x4){__expf(x[0]), __expf(x[1]), __expf(x[2]), __expf(x[3])}; }
__device__ __forceinline__ f32x4 sig4(const f32x4& x) { return (f32x4){1.f / (1.f + __expf(-x[0])), 1.f / (1.f + __expf(-x[1])), 1.f / (1.f + __expf(-x[2])), 1.f / (1.f + __expf(-x[3]))}; }
__device__ __forceinline__ float sum4sq(const f32x4& x) { return (x[0] * x[0] + x[1] * x[1]) + (x[2] * x[2] + x[3] * x[3]); }
__device__ __forceinline__ float row_rstd(const float* RS, int row) {
    const f32x4 a = *(const f32x4*)(RS + (size_t)row * 16), b = *(const f32x4*)(RS + (size_t)row * 16 + 4), c = *(const f32x4*)(RS + (size_t)row * 16 + 8), d = *(const f32x4*)(RS + (size_t)row * 16 + 12);
    const float ss = (((a[0] + a[1]) + (a[2] + a[3])) + ((b[0] + b[1]) + (b[2] + b[3]))) + (((c[0] + c[1]) + (c[2] + c[3])) + ((d[0] + d[1]) + (d[2] + d[3])));
    return rsqrtf(ss * (1.f / 1024.f) + EPS); }
#define EPI_LOOP_ROWS  _Pragma("unroll") for (int ai = 0; ai < 2; ++ai) _Pragma("unroll") for (int m = 0; m < 4; ++m)
#define EPI_LOOP_BJ    _Pragma("unroll") for (int bj = 0; bj < 2; ++bj)

struct EpiStore { static constexpr bool PERM = true, AFTER_DRAIN = false; bf16_t* O; int ldc;
    __device__ __forceinline__ void operator()(const f32x4 (&acc)[2][2][4][2], const Unit& u, int wr, int wc, int fr, int fq) const {
        const int row0 = u.pm * BM + wr * 64 + fr, col0 = u.pn * BM + wc * 32 + 8 * fq;
        EPI_LOOP_ROWS { bf16_t* rowp = O + (size_t)(row0 + ai * HALF + m * 16) * ldc + col0;
            EPI_LOOP_BJ *(u32x4*)(rowp + bj * HALF) = pack8(acc[ai][bj][m][0], acc[ai][bj][m][1]); } } };
struct EpiGla { static constexpr bool PERM = true, AFTER_DRAIN = false; bf16_t *QD, *KI, *KO, *V, *R; const float* BC;
    __device__ __forceinline__ void operator()(const f32x4 (&acc)[2][2][4][2], const Unit& u, int wr, int wc, int fr, int fq) const {
        const int row0 = u.pm * BM + wr * 64 + fr, cl = wc * 32 + 8 * fq;
        if (u.pn < 2) {
            EPI_LOOP_ROWS { const int row = row0 + ai * HALF + m * 16;
                EPI_LOOP_BJ { const size_t o = (size_t)row * 512 + u.pn * 256 + bj * HALF + cl;
                    const f32x4 b0 = *(const f32x4*)(BC + o), b1 = *(const f32x4*)(BC + o + 4);
                    *(u32x4*)(QD + o) = pack8(acc[ai][bj][m][0] * QSCALE * exp4(b0), acc[ai][bj][m][1] * QSCALE * exp4(b1)); } }
        } else if (u.pn < 4) {
            EPI_LOOP_ROWS { const int row = row0 + ai * HALF + m * 16;
                EPI_LOOP_BJ { const int c = (u.pn - 2) * 256 + bj * HALF + cl; const size_t o = (size_t)row * 512 + c, ol = (size_t)(row | 63) * 512 + c;
                    const f32x4 b0 = *(const f32x4*)(BC + o), b1 = *(const f32x4*)(BC + o + 4), l0 = *(const f32x4*)(BC + ol), l1 = *(const f32x4*)(BC + ol + 4);
                    *(u32x4*)(KI + o) = pack8(acc[ai][bj][m][0] * exp4(-b0), acc[ai][bj][m][1] * exp4(-b1));
                    *(u32x4*)(KO + o) = pack8(acc[ai][bj][m][0] * exp4(l0 - b0), acc[ai][bj][m][1] * exp4(l1 - b1)); } }
        } else {
            bf16_t* O = u.pn < 8 ? V : R; const int ct = (u.pn < 8 ? u.pn - 4 : u.pn - 8) * 256 + cl;
            EPI_LOOP_ROWS { bf16_t* rowp = O + (size_t)(row0 + ai * HALF + m * 16) * 1024 + ct;
                EPI_LOOP_BJ *(u32x4*)(rowp + bj * HALF) = pack8(acc[ai][bj][m][0], acc[ai][bj][m][1]); }
        } } };
struct EpiGate { static constexpr bool PERM = true, AFTER_DRAIN = false; bf16_t* SG;
    __device__ __forceinline__ void operator()(const f32x4 (&acc)[2][2][4][2], const Unit& u, int wr, int wc, int fr, int fq) const {
        const int row0 = u.pm * BM + wr * 64 + fr, col0 = (u.pn & 3) * BM + wc * 32 + 8 * fq; bf16_t* O = SG + (size_t)(u.pn >> 2) * M * 1024;
        EPI_LOOP_ROWS { bf16_t* rowp = O + (size_t)(row0 + ai * HALF + m * 16) * 1024 + col0;
            EPI_LOOP_BJ *(u32x4*)(rowp + bj * HALF) = pack8(sig4(acc[ai][bj][m][0]), sig4(acc[ai][bj][m][1])); } } };
struct EpiMulStore { static constexpr bool PERM = true, AFTER_DRAIN = false; const bf16_t* SGm; float* UF;
    __device__ __forceinline__ void operator()(const f32x4 (&acc)[2][2][4][2], const Unit& u, int wr, int wc, int fr, int fq) const {
        const int row0 = u.pm * BM + wr * 64 + fr, col0 = u.pn * BM + wc * 32 + 8 * fq;
        EPI_LOOP_ROWS { const size_t ro = (size_t)(row0 + ai * HALF + m * 16) * 1024 + col0;
            EPI_LOOP_BJ { f32x4 s0 = (f32x4){1.f, 1.f, 1.f, 1.f}, s1 = s0; if (SGm) unpack8(*(const u32x4*)(SGm + ro + bj * HALF), s0, s1);
                *(f32x4*)(UF + ro + bj * HALF) = s0 * acc[ai][bj][m][0]; *(f32x4*)(UF + ro + bj * HALF + 4) = s1 * acc[ai][bj][m][1]; } } } };
struct EpiMulAddStore { static constexpr bool PERM = true, AFTER_DRAIN = false; const bf16_t* SGm; const float* UF; bf16_t* U;
    __device__ __forceinline__ void operator()(const f32x4 (&acc)[2][2][4][2], const Unit& u, int wr, int wc, int fr, int fq) const {
        const int row0 = u.pm * BM + wr * 64 + fr, col0 = u.pn * BM + wc * 32 + 8 * fq;
        EPI_LOOP_ROWS { const size_t ro = (size_t)(row0 + ai * HALF + m * 16) * 1024 + col0;
            EPI_LOOP_BJ { f32x4 s0, s1; unpack8(*(const u32x4*)(SGm + ro + bj * HALF), s0, s1);
                const f32x4 t0 = *(const f32x4*)(UF + ro + bj * HALF), t1 = *(const f32x4*)(UF + ro + bj * HALF + 4);
                *(u32x4*)(U + ro + bj * HALF) = pack8(t0 + s0 * acc[ai][bj][m][0], t1 + s1 * acc[ai][bj][m][1]); } } } };
struct EpiResid { static constexpr bool PERM = true, AFTER_DRAIN = false; const float* xi; float* xo; bf16_t* XB; float* RS;
    __device__ __forceinline__ void operator()(const f32x4 (&acc)[2][2][4][2], const Unit& u, int wr, int wc, int fr, int fq) const {
        const int row0 = u.pm * BM + wr * 64 + fr, col0 = u.pn * BM + wc * 32 + 8 * fq;
        EPI_LOOP_ROWS { const int row = row0 + ai * HALF + m * 16; const size_t ro = (size_t)row * 1024 + col0; float ss = 0.f;
            EPI_LOOP_BJ { const f32x4 o0 = *(const f32x4*)(xi + ro + bj * HALF) + acc[ai][bj][m][0], o1 = *(const f32x4*)(xi + ro + bj * HALF + 4) + acc[ai][bj][m][1];
                *(f32x4*)(xo + ro + bj * HALF) = o0; *(f32x4*)(xo + ro + bj * HALF + 4) = o1; *(u32x4*)(XB + ro + bj * HALF) = pack8(o0, o1); ss += sum4sq(o0) + sum4sq(o1); }
            ss += __shfl_xor(ss, 16); ss += __shfl_xor(ss, 32);
            if (fq == 0) RS[(size_t)row * 16 + u.pn * 4 + wc] = ss; } } };
struct EpiMlp1 { static constexpr bool PERM = true, AFTER_DRAIN = false; const float* RS; bf16_t* H;
    __device__ __forceinline__ void operator()(const f32x4 (&acc)[2][2][4][2], const Unit& u, int wr, int wc, int fr, int fq) const {
        const int row0 = u.pm * BM + wr * 64 + fr, col0 = u.pn * BM + wc * 32 + 8 * fq;
        EPI_LOOP_ROWS { const int row = row0 + ai * HALF + m * 16; const float rstd = row_rstd(RS, row); bf16_t* rowp = H + (size_t)row * FF + col0;
            EPI_LOOP_BJ { f32x4 a = acc[ai][bj][m][0] * rstd, b = acc[ai][bj][m][1] * rstd;
                a = __builtin_elementwise_max(a, (f32x4){0.f, 0.f, 0.f, 0.f}); b = __builtin_elementwise_max(b, (f32x4){0.f, 0.f, 0.f, 0.f});
                *(u32x4*)(rowp + bj * HALF) = pack8(a * a, b * b); } } } };
struct EpiPle { static constexpr bool PERM = true, AFTER_DRAIN = false; const float* RS3; const float* T; float* x; float* RSo;
    __device__ __forceinline__ void operator()(const f32x4 (&acc)[2][2][4][2], const Unit& u, int wr, int wc, int fr, int fq) const {
        const int row0 = u.pm * BM + wr * 64 + fr, col0 = u.pn * BM + wc * 32 + 8 * fq;
        EPI_LOOP_ROWS { const int row = row0 + ai * HALF + m * 16; const float rstd = row_rstd(RS3, row); const size_t ro = (size_t)row * 1024 + col0; float ss = 0.f;
            EPI_LOOP_BJ { const f32x4 t0 = *(const f32x4*)(T + ro + bj * HALF), t1 = *(const f32x4*)(T + ro + bj * HALF + 4);
                const f32x4 o0 = *(const f32x4*)(x + ro + bj * HALF) + sig4(acc[ai][bj][m][0] * rstd) * t0, o1 = *(const f32x4*)(x + ro + bj * HALF + 4) + sig4(acc[ai][bj][m][1] * rstd) * t1;
                *(f32x4*)(x + ro + bj * HALF) = o0; *(f32x4*)(x + ro + bj * HALF + 4) = o1; ss += sum4sq(o0) + sum4sq(o1); }
            ss += __shfl_xor(ss, 16); ss += __shfl_xor(ss, 32);
            if (fq == 0) RSo[(size_t)row * 16 + u.pn * 4 + wc] = ss; } } };
struct OneUnit { Unit u;
    __device__ __forceinline__ bool next(int i, Unit& o) const { if (i) return false; o = u; return true; }
    __device__ __forceinline__ void a_ready(const Unit&) const {}
    __device__ __forceinline__ void done(const Unit&) const {} };
}
__device__ __forceinline__ float wave_sum(float v) {
#pragma unroll
    for (int o = 1; o < 64; o <<= 1) v += __shfl_xor(v, o);
    return v;
}
__device__ __forceinline__ void p0_transpose_item(const float* W, int ldw, int col0, int K, int N, const float* sc, bf16* WT, LAS float* scr, int item, int lane) {
    const int nblk = N / 32, kb = item / nblk, nb = item % nblk, k0 = 64 * kb, n0 = 32 * nb;
#pragma unroll 8
    for (int i = 0; i < 32; ++i) { const int kk = 2 * i + (lane >> 5); float v = W[(size_t)(k0 + kk) * ldw + col0 + n0 + (lane & 31)]; if (sc) v *= sc[k0 + kk]; scr[kk * 33 + (lane & 31)] = v; }
    LDS_WAIT(); asm volatile("" ::: "memory");
    const int c = lane & 7;
#pragma unroll
    for (int j = 0; j < 4; ++j) { const int n = (lane >> 3) + 8 * j; const LAS float* s = scr + (8 * c) * 33 + n;
        v4u o; o.x = pk2(s[0 * 33], s[1 * 33]); o.y = pk2(s[2 * 33], s[3 * 33]); o.z = pk2(s[4 * 33], s[5 * 33]); o.w = pk2(s[6 * 33], s[7 * 33]);
        *(GAS v4u*)(WT + (size_t)(n0 + n) * K + k0 + 8 * c) = o; }
    LDS_WAIT(); asm volatile("" ::: "memory");
}
struct Ptrs {
    const float *x, *p, *ln1, *w_in, *w_a2, *b_a, *gla_gn, *w_o_gla, *w_o_attn, *w_out, *ln2, *w_mlp1, *w_mlp2, *ln3, *w_pp, *w_pg, *rel_bias, *ln_f;
    float* out; unsigned char* ws;
};
__device__ __forceinline__ void p0_chunk(const Ptrs& P, int chunk, LAS float* ha  , int tid) {
    const int lane = tid & 63, wave = tid >> 6;
    bf16* XN = (bf16*)(P.ws + WS_XN); float* BC = (float*)((char*)P.out + DO_BC); float* DEC = (float*)(P.ws + WS_DEC);
    for (int rr = 0; rr < 8; ++rr) {
        const int r = wave * 8 + rr; const size_t row = (size_t)chunk * 64 + r;
        float ss = 0.f;
#pragma unroll
        for (int j = 0; j < 4; ++j) { const f32x4 v = *(const f32x4*)(P.x + row * D + 256 * j + 4 * lane); ss += v[0] * v[0] + v[1] * v[1] + v[2] * v[2] + v[3] * v[3]; }
        ss = wave_sum(ss); const float rstd = rsqrtf(ss * (1.f / D) + EPS);
        float acc[16];
#pragma unroll
        for (int o = 0; o < 16; ++o) acc[o] = 0.f;
#pragma unroll 1
        for (int j = 0; j < 4; ++j) {
            const int c0 = 256 * j + 4 * lane;
            const f32x4 v = *(const f32x4*)(P.x + row * D + c0); const f32x4 g = *(const f32x4*)(P.ln1 + c0);
            float h[4];
#pragma unroll
            for (int e = 0; e < 4; ++e) { h[e] = v[e] * rstd * g[e];
                const float* wr = P.w_in + (size_t)(c0 + e) * IN_COLS + C_A;
#pragma unroll
                for (int o = 0; o < 16; ++o) acc[o] += h[e] * wr[o]; }
            *(uint2*)(XN + row * D + c0) = make_uint2(pk2(h[0], h[1]), pk2(h[2], h[3]));
        }
#pragma unroll
        for (int o = 0; o < 16; ++o) { const float s = wave_sum(acc[o]); if (lane == 0) ha[r * 16 + o] = s; }
    }
    __syncthreads();
    {   const int t = tid; float w[16];
#pragma unroll
        for (int j = 0; j < 16; ++j) w[j] = P.w_a2[j * 512 + t];
        const float bb = P.b_a[t]; float cum = 0.f;
        for (int r = 0; r < 64; ++r) {
            float z = bb;
#pragma unroll
            for (int j = 0; j < 16; ++j) z += ha[r * 16 + j] * w[j];
            const float ls = fminf(z, 0.f) - log1pf(expf(-fabsf(z)));
            cum += ls * (1.f / 16.f);
            BC[((size_t)chunk * 64 + r) * 512 + t] = cum;
        }
        DEC[(size_t)chunk * 512 + t] = expf(cum);
    }
    __syncthreads();
}
__device__ __forceinline__ void p0_prologue(const Ptrs& P, LAS unsigned char* lds, int vcu, int G, int tid) {
    const int lane = tid & 63, wave = __builtin_amdgcn_readfirstlane(tid >> 6);
    LAS float* scr = (LAS float*)(lds + RING_OFF + wave * 16384);
    const int gw = vcu * NWAVES + wave, NGW = G * NWAVES;
    unsigned char* ws = P.ws;
    constexpr int I_ATT = (D / 64) * (N_ATT / 32), I_GLA = (D / 64) * (N_GLA / 32), I_GATE = (D / 64) * (N_GATE / 32), I_SQ = (D / 64) * (D / 32), I_OATT = (512 / 64) * (D / 32),
                  I_1 = (D / 64) * (FF / 32), I_2 = (FF / 64) * (D / 32), I_PP = (PLE / 64) * (D / 32);
    constexpr int NITEMS = I_ATT + I_GLA + I_GATE + 3 * I_SQ + I_OATT + I_1 + I_2 + I_PP;
    for (int it = gw; it < NITEMS; it += NGW) {
        int r = it;
        if (r < I_ATT) { p0_transpose_item(P.w_in, IN_COLS, C_ATT, D, N_ATT, nullptr, (bf16*)(ws + WS_WATT), scr, r, lane); continue; } r -= I_ATT;
        if (r < I_GLA) { p0_transpose_item(P.w_in, IN_COLS, C_Q, D, N_GLA, nullptr, (bf16*)(ws + WS_WGLA), scr, r, lane); continue; } r -= I_GLA;
        if (r < I_GATE) { p0_transpose_item(P.w_in, IN_COLS, C_GATE, D, N_GATE, nullptr, (bf16*)(ws + WS_WGATE), scr, r, lane); continue; } r -= I_GATE;
        if (r < I_SQ) { p0_transpose_item(P.w_o_gla, D, 0, D, D, nullptr, (bf16*)(ws + WS_WOGLA), scr, r, lane); continue; } r -= I_SQ;
        if (r < I_SQ) { p0_transpose_item(P.w_out, D, 0, D, D, nullptr, (bf16*)(ws + WS_WOUT), scr, r, lane); continue; } r -= I_SQ;
        if (r < I_SQ) { p0_transpose_item(P.w_pg, D, 0, D, D, P.ln3, (bf16*)(ws + WS_WPG), scr, r, lane); continue; } r -= I_SQ;
        if (r < I_OATT) { p0_transpose_item(P.w_o_attn, D, 0, 512, D, nullptr, (bf16*)(ws + WS_WOATT), scr, r, lane); continue; } r -= I_OATT;
        if (r < I_1) { p0_transpose_item(P.w_mlp1, FF, 0, D, FF, P.ln2, (bf16*)(ws + WS_W1), scr, r, lane); continue; } r -= I_1;
        if (r < I_2) { p0_transpose_item(P.w_mlp2, D, 0, FF, D, nullptr, (bf16*)(ws + WS_W2), scr, r, lane); continue; } r -= I_2;
        p0_transpose_item(P.w_pp, D, 0, PLE, D, nullptr, (bf16*)(ws + WS_WPP), scr, r, lane);
    }
    { const size_t nv = (size_t)M * PLE / 8; bf16* PB = (bf16*)(ws + WS_PB);
      for (size_t i = (size_t)vcu * 512 + tid; i < nv; i += (size_t)G * 512) { const f32x4 a = *(const f32x4*)(P.p + i * 8), b = *(const f32x4*)(P.p + i * 8 + 4);
          v4u o; o.x = pk2(a[0], a[1]); o.y = pk2(a[2], a[3]); o.z = pk2(b[0], b[1]); o.w = pk2(b[2], b[3]); *(v4u*)(PB + i * 8) = o; } }
    { const int i = vcu * 512 + tid;
      if (i < 3 * 4 * 129) { const int g = i / (4 * 129), hh = (i / 129) % 4, dl = i % 129; const int dil = g == 0 ? 1 : (g == 1 ? 4 : 16); const int n = dl * dil;
          int bucket; if (n < 16) bucket = n; else { const int l = 16 + (int)(log((double)n / 16.0) / log(128.0) * 16.0); bucket = l < 31 ? l : 31; }
          ((float*)(ws + WS_LUT))[i] = P.rel_bias[bucket * 12 + g * 4 + hh]; } }
    __syncthreads();
    for (int chunk = vcu; chunk < NCHUNK; chunk += G) p0_chunk(P, chunk, (LAS float*)(lds + RING_OFF), tid);
}
__device__ __forceinline__ float bf2f(bf16 v) { return __uint_as_float((unsigned)v << 16); }
typedef unsigned u32x4n __attribute__((ext_vector_type(4)));
__global__ void __launch_bounds__(256) k_attn(const bf16* __restrict__ QKV, const float* __restrict__ LUT, bf16* __restrict__ OATT) {
    __shared__ float Pm[4][3 * 129 + 1];
    const int lane = threadIdx.x & 63, w = threadIdx.x >> 6;
    const int task = blockIdx.x * 4 + w; const int row = task >> 2, hh = task & 3;
    const int b = row / SEQ, t = row % SEQ;
    float lg[3][3]; float mx = -1e30f;
#pragma unroll
    for (int g = 0; g < 3; ++g) {
        const int dil = g == 0 ? 1 : (g == 1 ? 4 : 16);
        const bf16* q = QKV + (size_t)row * N_ATT + g * 1536 + hh * 128;
        u32x4n qv[16];
#pragma unroll
        for (int i = 0; i < 16; ++i) qv[i] = *(const u32x4n*)(q + 8 * i);
#pragma unroll
        for (int rd = 0; rd < 3; ++rd) {
            const int dl = lane + 64 * rd; float v = -1e30f;
            if (dl <= 128 && t - dl * dil >= 0) {
                const bf16* k = QKV + (size_t)(b * SEQ + t - dl * dil) * N_ATT + g * 1536 + 512 + hh * 128;
                float s = 0.f;
#pragma unroll
                for (int i = 0; i < 16; ++i) { const u32x4n kv = *(const u32x4n*)(k + 8 * i);
#pragma unroll
                    for (int e = 0; e < 4; ++e) s += __uint_as_float(qv[i][e] << 16) * __uint_as_float(kv[e] << 16) + __uint_as_float(qv[i][e] & 0xffff0000u) * __uint_as_float(kv[e] & 0xffff0000u); }
                v = s * QSCALE + LUT[(g * 4 + hh) * 129 + dl];
            }
            lg[g][rd] = v; mx = fmaxf(mx, v);
        }
    }
#pragma unroll
    for (int o = 1; o < 64; o <<= 1) mx = fmaxf(mx, __shfl_xor(mx, o));
    float sum = 0.f;
#pragma unroll
    for (int g = 0; g < 3; ++g)
#pragma unroll
        for (int rd = 0; rd < 3; ++rd) { const int dl = lane + 64 * rd; const float p = lg[g][rd] > -1e29f ? __expf(lg[g][rd] - mx) : 0.f; sum += p; if (dl <= 128) Pm[w][g * 129 + dl] = p; }
    sum = wave_sum(sum);
    __syncthreads();
    float o0 = 0.f, o1 = 0.f;
    for (int g = 0; g < 3; ++g) {
        const int dil = g == 0 ? 1 : (g == 1 ? 4 : 16);
        for (int dl = 0; dl <= 128; ++dl) {
            if (t - dl * dil < 0) break;
            const float p = Pm[w][g * 129 + dl];
            const unsigned vv = *(const unsigned*)(QKV + (size_t)(b * SEQ + t - dl * dil) * N_ATT + g * 1536 + 1024 + hh * 128 + 2 * lane);
            o0 += p * __uint_as_float(vv << 16); o1 += p * __uint_as_float(vv & 0xffff0000u);
        }
    }
    const float inv = 1.f / sum;
    *(unsigned*)(OATT + (size_t)row * 512 + hh * 128 + 2 * lane) = pk2(o0 * inv, o1 * inv);
}
__global__ void __launch_bounds__(256) k_gla(const bf16* __restrict__ QD, const bf16* __restrict__ KI, const bf16* __restrict__ KO, const bf16* __restrict__ V,
                                             const bf16* __restrict__ R, const float* __restrict__ DEC, const float* __restrict__ gn, bf16* __restrict__ OGLA) {
    __shared__ float sq[64][129], sko[64][129], att[64][65], red[64][4];
    __shared__ float ski[64][129];
    const int tid = threadIdx.x, b = blockIdx.x >> 2, h = blockIdx.x & 3;
    float S[128];
#pragma unroll
    for (int d = 0; d < 128; ++d) S[d] = 0.f;
    for (int n = 0; n < 128; ++n) {
        const size_t row0 = (size_t)b * SEQ + n * 64;
        __syncthreads();
        for (int i = tid; i < 64 * 128; i += 256) { const int c = i >> 7, d = i & 127; const size_t o = (row0 + c) * 512 + h * 128 + d; sq[c][d] = bf2f(QD[o]); ski[c][d] = bf2f(KI[o]); sko[c][d] = bf2f(KO[o]); }
        __syncthreads();
        for (int i = tid; i < 64 * 64; i += 256) { const int c = i >> 6, s = i & 63; float a = 0.f; if (s <= c) { for (int d = 0; d < 128; ++d) a += sq[c][d] * ski[s][d]; } att[c][s] = a; }
        __syncthreads();
        float vcol[64];
#pragma unroll
        for (int s = 0; s < 64; ++s) vcol[s] = bf2f(V[(row0 + s) * 1024 + h * 256 + tid]);
        const float g = gn[h * 256 + tid];
        for (int c = 0; c < 64; ++c) {
            float o = 0.f;
#pragma unroll
            for (int d = 0; d < 128; ++d) o += sq[c][d] * S[d];
#pragma unroll
            for (int s = 0; s < 64; ++s) o += att[c][s] * vcol[s];
            const float ss = wave_sum(o * o);
            __syncthreads();
            if ((tid & 63) == 0) red[c][tid >> 6] = ss;
            __syncthreads();
            const float tot = red[c][0] + red[c][1] + red[c][2] + red[c][3];
            const float rstd = rsqrtf(tot * (1.f / 256.f) + EPS);
            const float r = bf2f(R[(row0 + c) * 1024 + h * 256 + tid]);
            const float silu = r / (1.f + __expf(-r));
            OGLA[(row0 + c) * 1024 + h * 256 + tid] = (bf16)f2bf(o * rstd * g * silu);
        }
        const float* dec = DEC + (size_t)(b * 128 + n) * 512 + h * 128;
#pragma unroll
        for (int d = 0; d < 128; ++d) { float u = 0.f;
#pragma unroll
            for (int s = 0; s < 64; ++s) u += sko[s][d] * vcol[s];
            S[d] = dec[d] * S[d] + u; }
    }
}
#define PHASE_ATTN
#define PHASE_GLA1
#define PHASE_GLA_SCAN
#define PHASE_GLA2
#define LAUNCH_PLAN \
    launch_mega(P, 0, 1, 0, grid, stream); launch_mega(P, 1, 2, 0, grid, stream); \
    k_attn<<<M, 256, 0, stream>>>((const bf16*)((char*)d_ws + WS_QKVA), (const float*)((char*)d_ws + WS_LUT), (bf16*)((char*)d_out + DO_OATT)); \
    launch_mega(P, 3, 4, 0, grid, stream); \
    k_gla<<<8, 256, 0, stream>>>((const bf16*)((char*)d_ws + WS_QD), (const bf16*)((char*)d_ws + WS_KI), (const bf16*)((char*)d_ws + WS_KO), (const bf16*)((char*)d_ws + WS_V), (const bf16*)((char*)d_ws + WS_RG), (const float*)((char*)d_ws + WS_DEC), P.gla_gn, (bf16*)((char*)d_out + DO_OGLA)); \
    for (int ph = 7; ph < N_PHASES; ++ph) launch_mega(P, ph, ph + 1, 0, grid, stream);
struct Args { Ptrs P; int ph_lo, ph_hi, li, pad; };
constexpr int N_PHASES = 13;
__global__ void __launch_bounds__(NWAVES * 64, 2) mega(Args args) {
    extern __shared__ __attribute__((aligned(16))) unsigned char lds_raw[];
    LAS unsigned char* lds = (LAS unsigned char*)lds_raw;
    const Ptrs& P = args.P;
    const int tid = threadIdx.x, lane = tid & 63, wave = __builtin_amdgcn_readfirstlane(tid >> 6);
    const int G = gridDim.x; const int bx = blockIdx.x; const int vcu = (G % 8 == 0) ? (bx % 8) * (G / 8) + bx / 8 : bx;
    unsigned char* ws = P.ws; gu32* ctl = (gu32*)(ws + WS_CTL);
    volatile LAS unsigned* MISC = (volatile LAS unsigned*)(lds + MISC_OFF);
    for (int u = tid; u < (LDS_BYTES - LDSCTL_OFF) / 4; u += NWAVES * 64) ((LAS unsigned*)(lds + LDSCTL_OFF))[u] = 0u;
    __syncthreads();
    const int lo = args.ph_lo, hi = args.ph_hi;
    XcdBarrier bar; bar.bar = (unsigned*)(ctl + CW_BAR) + args.li * XCD_BAR_WORDS; bar.x = 0; bar.st = nullptr;
    if (hi - lo > 1) bar = xcd_barrier_post((unsigned*)(ctl + CW_BAR) + args.li * XCD_BAR_WORDS, MISC + 8);
#define IN(k) (lo <= (k) && (k) < hi)
#define SEAM(k) do { if (IN(k) && IN((k) + 1)) xcd_barrier(bar); } while (0)
    bf16* XN = (bf16*)(ws + WS_XN);
    float* RS2 = (float*)(ws + WS_RS2); float* RS3 = (float*)(ws + WS_RS3);
    pg8::Unit my; { pg8::StaticOrder S; S.init(M, D, G, bx); if (!S.next(0, my)) { my.pm = 0; my.pn = 0; } }

    if (IN(0)) { p0_prologue(P, lds, vcu, G, tid); } SEAM(0);
    if (IN(1)) { pg8::Gemm g{XN, (const bf16*)(ws + WS_WATT), M, N_ATT, D}; pg8::StaticOrder S; S.init(M, N_ATT, G, bx);
        epi::EpiStore E{(bf16*)(ws + WS_QKVA), N_ATT};
        pg8::gemm_phase<epi::EpiStore, pg8::StaticOrder, true, true>(lds + RING_OFF, g, S, E); } SEAM(1);
    if (IN(2)) { PHASE_ATTN } SEAM(2);
    if (IN(3)) { pg8::Gemm g{XN, (const bf16*)(ws + WS_WGLA), M, N_GLA, D}; pg8::StaticOrder S; S.init(M, N_GLA, G, bx);
        epi::EpiGla E{(bf16*)(ws + WS_QD), (bf16*)(ws + WS_KI), (bf16*)(ws + WS_KO), (bf16*)(ws + WS_V), (bf16*)(ws + WS_RG), (const float*)((char*)P.out + DO_BC)};
        pg8::gemm_phase<epi::EpiGla, pg8::StaticOrder, true, true>(lds + RING_OFF, g, S, E); } SEAM(3);
    if (IN(4)) { PHASE_GLA1 } SEAM(4);
    if (IN(5)) { PHASE_GLA_SCAN } SEAM(5);
    if (IN(6)) { PHASE_GLA2 } SEAM(6);
    if (IN(7)) {
        const bf16* SG = (const bf16*)(ws + WS_SG); float* UF = (float*)(ws + WS_UF);
        { pg8::Gemm g{XN, (const bf16*)(ws + WS_WGATE), M, N_GATE, D}; epi::OneUnit S{{my.pm, my.pn}}; epi::EpiGate E{(bf16*)(ws + WS_SG)};
          pg8::gemm_phase<epi::EpiGate, epi::OneUnit, false, true>(lds + RING_OFF, g, S, E); }
        { pg8::Gemm g{XN, (const bf16*)(ws + WS_WGATE), M, N_GATE, D}; epi::OneUnit S{{my.pm, 4 + my.pn}}; epi::EpiGate E{(bf16*)(ws + WS_SG)};
          pg8::gemm_phase<epi::EpiGate, epi::OneUnit, false, true>(lds + RING_OFF, g, S, E); }
        { pg8::Gemm g{(const bf16*)((char*)P.out + DO_OATT), (const bf16*)(ws + WS_WOATT), M, D, 512}; epi::OneUnit S{my}; epi::EpiMulStore E{SG + (size_t)M * 1024, UF};
          pg8::gemm_phase<epi::EpiMulStore, epi::OneUnit, false, true>(lds + RING_OFF, g, S, E); }
        { pg8::Gemm g{(const bf16*)((char*)P.out + DO_OGLA), (const bf16*)(ws + WS_WOGLA), M, D, D}; epi::OneUnit S{my}; epi::EpiMulAddStore E{SG, UF, (bf16*)(ws + WS_U)};
          pg8::gemm_phase<epi::EpiMulAddStore, epi::OneUnit, false, true>(lds + RING_OFF, g, S, E); }
    } SEAM(7);
    if (IN(8)) { pg8::Gemm g{(const bf16*)(ws + WS_U), (const bf16*)(ws + WS_WOUT), M, D, D}; epi::OneUnit S{my};
        epi::EpiResid E{P.x, P.out, (bf16*)(ws + WS_X1B), RS2};
        pg8::gemm_phase<epi::EpiResid, epi::OneUnit, false, true>(lds + RING_OFF, g, S, E); } SEAM(8);
    if (IN(9)) { pg8::Gemm g{(const bf16*)(ws + WS_X1B), (const bf16*)(ws + WS_W1), M, FF, D}; pg8::StaticOrder S; S.init(M, FF, G, bx);
        epi::EpiMlp1 E{RS2, (bf16*)(ws + WS_H)};
        pg8::gemm_phase<epi::EpiMlp1, pg8::StaticOrder, true, true>(lds + RING_OFF, g, S, E); } SEAM(9);
    if (IN(10)) { pg8::Gemm g{(const bf16*)(ws + WS_H), (const bf16*)(ws + WS_W2), M, D, FF}; epi::OneUnit S{my};
        epi::EpiResid E{P.out, P.out, (bf16*)(ws + WS_X1B), RS3};
        pg8::gemm_phase<epi::EpiResid, epi::OneUnit, false, true>(lds + RING_OFF, g, S, E); } SEAM(10);
    if (IN(11)) {
        float* UF = (float*)(ws + WS_UF);
        { pg8::Gemm g{(const bf16*)(ws + WS_PB), (const bf16*)(ws + WS_WPP), M, D, PLE}; epi::OneUnit S{my}; epi::EpiMulStore E{nullptr, UF};
          pg8::gemm_phase<epi::EpiMulStore, epi::OneUnit, false, true>(lds + RING_OFF, g, S, E); }
        { pg8::Gemm g{(const bf16*)(ws + WS_X1B), (const bf16*)(ws + WS_WPG), M, D, D}; epi::OneUnit S{my}; epi::EpiPle E{RS3, UF, P.out, RS2};
          pg8::gemm_phase<epi::EpiPle, epi::OneUnit, false, true>(lds + RING_OFF, g, S, E); }
    } SEAM(11);
    if (IN(12)) {
        for (int row = vcu * NWAVES + wave; row < M; row += G * NWAVES) { const float rstd = epi::row_rstd(RS2, row);
#pragma unroll
            for (int j = 0; j < 4; ++j) { float* o = P.out + (size_t)row * D + 256 * j + 4 * lane; *(f32x4*)o = *(const f32x4*)o * rstd * *(const f32x4*)(P.ln_f + 256 * j + 4 * lane); } }
    }
#undef IN
#undef SEAM
}
static void launch_mega(const Ptrs& P, int lo, int hi, int li, int grid, hipStream_t stream) {
    Args a{}; a.P = P; a.ph_lo = lo; a.ph_hi = hi; a.li = li; a.pad = 0;
    hipLaunchKernelGGL(mega, dim3(grid), dim3(NWAVES * 64), LDS_BYTES, stream, a);
}
extern "C" void kernel_launch(void* const* d_in, const int* in_sizes, int n_in, void* d_out, int out_size, void* d_ws, size_t ws_size, hipStream_t stream) {
    static int grid = 0;
    if (grid == 0) {
        if (n_in != 18 || ws_size < WS_END || out_size != M * D) { fprintf(stderr, "kernel_launch: unexpected shapes (n_in %d ws %zu out %d)\n", n_in, ws_size, out_size); grid = -1; return; }
        int dev = 0, cus = 0;
        if (hipGetDevice(&dev) != hipSuccess || hipDeviceGetAttribute(&cus, hipDeviceAttributeMultiprocessorCount, dev) != hipSuccess) { grid = -1; return; }
        if (hipFuncSetAttribute((const void*)mega, hipFuncAttributeMaxDynamicSharedMemorySize, LDS_BYTES) != hipSuccess) { fprintf(stderr, "kernel_launch: hipFuncSetAttribute failed\n"); grid = -1; return; }
        int per_cu = 0; (void)hipOccupancyMaxActiveBlocksPerMultiprocessor(&per_cu, (const void*)mega, NWAVES * 64, LDS_BYTES); (void)hipGetLastError();
        if (per_cu < 1) fprintf(stderr, "kernel_launch: occupancy query says %d blocks per CU\n", per_cu);
        grid = cus;
        if (grid != 256) fprintf(stderr, "kernel_launch: %d CUs; this kernel is laid out for 256\n", grid);
    }
    if (grid < 0) return;
    Ptrs P{};
    const float** pp = (const float**)&P;
    for (int i = 0; i < 18; ++i) pp[i] = (const float*)d_in[i];
    P.out = (float*)d_out; P.ws = (unsigned char*)d_ws;
    (void)hipMemsetAsync((char*)d_ws + WS_CTL, 0, CTL_ZERO_BYTES, stream);
    LAUNCH_PLAN
}
```

```cpp
#include <hip/hip_runtime.h>
#include <cstdint>
#include <cstdio>
namespace pg8 {
#define PG8_LAS __attribute__((address_space(3)))
typedef unsigned short bf16_t;
typedef short bf16x8 __attribute__((ext_vector_type(8)));
typedef float f32x4 __attribute__((ext_vector_type(4)));
typedef unsigned u32x4 __attribute__((ext_vector_type(4)));
constexpr int BM = 256, BK = 64, HALF = 128, HTB = HALF * BK * 2  , STAGE_BYTES = 8 * HTB, NXCD = 8, WGM = 8;

__host__ __device__ __forceinline__ int lds_byte(int r, int c) { const int st = (r >> 4) * 2 + (c >> 5), rr = r & 15, cc = c & 31, ob = rr * 64 + cc * 2; return st * 1024 + (ob ^ (((ob >> 9) & 1) << 5)); }
__host__ __device__ __forceinline__ void stage_rc(int b, int& R, int& C) { const int st = b / 1024, sb = b % 1024, swz = sb ^ (((sb >> 9) & 1) << 5); R = (st >> 1) * 16 + swz / 64; C = (st & 1) * 32 + (swz % 64) / 2; }
__host__ __device__ __forceinline__ int perm32(int rho) { const int n = rho >> 4, i = rho & 15; return 8 * (i >> 2) + 4 * n + (i & 3); }

struct Unit { int pm, pn; };
struct Gemm { const bf16_t* A; const bf16_t* Bt; int M, N, K; };

struct StaticOrder {
    int nM, nN, nwg, G, c;
    __host__ __device__ void init(int M, int N, int G_, int c_) { nM = M / BM; nN = N / BM; nwg = nM * nN; G = G_; c = c_; }
    __host__ __device__ bool next(int i, Unit& u) const {
        const long L = (long)i * G + c; if (L >= nwg) return false;
        int wgid = (int)L; { const int q = nwg / NXCD, r = nwg % NXCD, xcd = wgid % NXCD, off = wgid / NXCD; wgid = (xcd < r ? xcd * (q + 1) : r * (q + 1) + (xcd - r) * q) + off; }
        const int nig = WGM * nN, gid = wgid / nig, fm = gid * WGM, gsz = (nM - fm) < WGM ? (nM - fm) : WGM;
        u.pm = fm + ((wgid % nig) % gsz); u.pn = (wgid % nig) / gsz; return true;
    }
    __device__ __forceinline__ void a_ready(const Unit&) const {}
    __device__ __forceinline__ void done(const Unit&) const {}
};

__device__ __forceinline__ unsigned cvt_pk_bf16(float lo, float hi) { unsigned r; asm volatile("v_cvt_pk_bf16_f32 %0, %1, %2" : "=v"(r) : "v"(lo), "v"(hi)); return r; }
typedef float f32x2 __attribute__((ext_vector_type(2)));
template <class Epi, class Sched, bool ALIGN_EPI = false, bool SP2 = false>
__device__ __forceinline__ void gemm_phase(PG8_LAS unsigned char* lds, const Gemm g, const Sched& S, const Epi& E) {
    const int tid = threadIdx.x, wid = __builtin_amdgcn_readfirstlane(tid >> 6), lane = tid & 63, wr = wid >> 2, wc = wid & 3, fr = lane & 15, fq = lane >> 4;
    const int K = g.K, nt = K / BK;
    unsigned voffA[2], voffB[2];
#pragma unroll
    for (int i = 0; i < 2; ++i) { int R, C; stage_rc(tid * 16 + i * 8192, R, C); const int Rb = Epi::PERM ? ((R & ~31) + perm32(R & 31)) : R;
        voffA[i] = (unsigned)(R * K + C) * 2u; voffB[i] = (unsigned)(Rb * K + C) * 2u; }
    const size_t kstep = (size_t)(BK * 2);
    const size_t hstep = (size_t)HALF * K * 2;
    const size_t tstep = 2 * hstep;
    const unsigned ldsw = (unsigned)wid * 1024u;
    const int aoff = lds_byte(wr * 64 + fr, fq * 8), boff = lds_byte(wc * 32 + fr, fq * 8);
#define PG8_SA(b, h) (((b) * 2 + (h)) * HTB)
#define PG8_SB(b, h) ((4 + (b) * 2 + (h)) * HTB)
#define PG8_STAGE(bufoff, gbase, voff) do { _Pragma("unroll") for (int _i = 0; _i < 2; ++_i) \
        __builtin_amdgcn_global_load_lds((const unsigned*)((const char*)(gbase) + (voff)[_i]), (PG8_LAS unsigned*)(lds + (bufoff) + ldsw + _i * 8192), 16, 0, 0); } while (0)
#define PG8_LDA(dst, b, h) do { _Pragma("unroll") for (int m = 0; m < 4; ++m) _Pragma("unroll") for (int k = 0; k < 2; ++k) dst[m][k] = *(const PG8_LAS bf16x8*)(lds + PG8_SA(b, h) + aoff + m * 2048 + k * 1024); } while (0)
#define PG8_LDB(dst, b, h) do { _Pragma("unroll") for (int n = 0; n < 2; ++n) _Pragma("unroll") for (int k = 0; k < 2; ++k) dst[n][k] = *(const PG8_LAS bf16x8*)(lds + PG8_SB(b, h) + boff + n * 2048 + k * 1024); } while (0)
#define PG8_MMA(ai, bj, At, Bt) do { __builtin_amdgcn_s_setprio(1); _Pragma("unroll") for (int m = 0; m < 4; ++m) _Pragma("unroll") for (int n = 0; n < 2; ++n) _Pragma("unroll") for (int k = 0; k < 2; ++k) \
        acc[ai][bj][m][n] = __builtin_amdgcn_mfma_f32_16x16x32_bf16(Bt[n][k], At[m][k], acc[ai][bj][m][n], 0, 0, 0); __builtin_amdgcn_s_setprio(0); } while (0)
#define PG8_WAIT_V(n) asm volatile("s_waitcnt vmcnt(" #n ")" ::: "memory")
#define PG8_WAIT_L(n) asm volatile("s_waitcnt lgkmcnt(" #n ")" ::: "memory")
#define PG8_BAR __builtin_amdgcn_s_barrier()
#define PG8_SCHED __builtin_amdgcn_sched_barrier(0)
    Unit cur, nxt; int ui = 0;
    if (!S.next(0, cur)) return;
    f32x4 acc[2][2][4][2];
#pragma unroll
    for (int a = 0; a < 2; ++a)
#pragma unroll
        for (int b = 0; b < 2; ++b)
#pragma unroll
            for (int m = 0; m < 4; ++m)
#pragma unroll
                for (int n = 0; n < 2; ++n) acc[a][b][m][n] = (f32x4){0.f, 0.f, 0.f, 0.f};
    bf16x8 At[4][2], B0[2][2], B1[2][2];
    const char* cA = (const char*)g.A + (size_t)cur.pm * tstep; const char* cB = (const char*)g.Bt + (size_t)cur.pn * tstep;
    S.a_ready(cur);
    if constexpr (SP2) {
        PG8_STAGE(PG8_SB(0, 0), cB, voffB); PG8_STAGE(PG8_SB(0, 1), cB + hstep, voffB); PG8_STAGE(PG8_SA(0, 0), cA, voffA); PG8_STAGE(PG8_SA(0, 1), cA + hstep, voffA);
        if (wr == 1) PG8_BAR;
        PG8_WAIT_V(2); PG8_BAR;
        PG8_STAGE(PG8_SB(1, 0), cB + kstep, voffB); PG8_STAGE(PG8_SA(1, 0), cA + kstep, voffA); PG8_STAGE(PG8_SB(1, 1), cB + hstep + kstep, voffB);
        PG8_WAIT_V(6); PG8_BAR;
    } else {
        PG8_STAGE(PG8_SB(0, 0), cB, voffB); PG8_STAGE(PG8_SA(0, 0), cA, voffA); PG8_STAGE(PG8_SB(0, 1), cB + hstep, voffB); PG8_STAGE(PG8_SA(0, 1), cA + hstep, voffA);
        if (wr == 1) PG8_BAR;
        PG8_WAIT_V(4); PG8_BAR;
        PG8_STAGE(PG8_SB(1, 0), cB + kstep, voffB); PG8_STAGE(PG8_SA(1, 0), cA + kstep, voffA); PG8_STAGE(PG8_SB(1, 1), cB + hstep + kstep, voffB);
        PG8_WAIT_V(6); PG8_BAR;
    }
    for (;;) {
        const bool has_next = S.next(ui + 1, nxt);
        const char* nA = has_next ? (const char*)g.A + (size_t)nxt.pm * tstep : cA; const char* nB = has_next ? (const char*)g.Bt + (size_t)nxt.pn * tstep : cB;
        for (int t = 0; t < nt; t += 2) {
            const bool last = (t == nt - 2);
            const char* a1 = cA + (size_t)(t + 1) * kstep;
            const char* a2 = last ? nA : cA + (size_t)(t + 2) * kstep; const char* b2 = last ? nB : cB + (size_t)(t + 2) * kstep;
            const char* a3 = a2 + kstep; const char* b3 = b2 + kstep;
            if (last && has_next) S.a_ready(nxt);
            if constexpr (SP2) {
            PG8_LDB(B0, 0, 0); PG8_LDB(B1, 0, 1); PG8_SCHED; PG8_LDA(At, 0, 0); PG8_STAGE(PG8_SA(1, 1), a1 + hstep, voffA);
            PG8_WAIT_V(8); PG8_WAIT_L(0); PG8_BAR; PG8_MMA(0, 0, At, B0); PG8_MMA(0, 1, At, B1); PG8_BAR; PG8_SCHED;
            PG8_LDA(At, 0, 1); PG8_STAGE(PG8_SB(0, 0), b2, voffB); PG8_STAGE(PG8_SB(0, 1), b2 + hstep, voffB); PG8_STAGE(PG8_SA(0, 0), a2, voffA);
            PG8_WAIT_V(8); PG8_WAIT_L(0); PG8_BAR; PG8_MMA(1, 0, At, B0); PG8_MMA(1, 1, At, B1); PG8_BAR; PG8_SCHED;
            PG8_LDB(B0, 1, 0); PG8_LDB(B1, 1, 1); PG8_SCHED; PG8_LDA(At, 1, 0); PG8_STAGE(PG8_SA(0, 1), a2 + hstep, voffA);
            PG8_WAIT_V(8); PG8_WAIT_L(0); PG8_BAR; PG8_MMA(0, 0, At, B0); PG8_MMA(0, 1, At, B1); PG8_BAR; PG8_SCHED;
            PG8_LDA(At, 1, 1); PG8_STAGE(PG8_SB(1, 0), b3, voffB); PG8_STAGE(PG8_SB(1, 1), b3 + hstep, voffB); PG8_STAGE(PG8_SA(1, 0), a3, voffA);
            PG8_WAIT_V(8); PG8_WAIT_L(0); PG8_BAR; PG8_MMA(1, 0, At, B0); PG8_MMA(1, 1, At, B1); PG8_BAR; PG8_SCHED;
            } else {
            PG8_LDB(B0, 0, 0); PG8_SCHED; PG8_LDA(At, 0, 0); PG8_STAGE(PG8_SA(1, 1), a1 + hstep, voffA);
            PG8_WAIT_L(8); PG8_BAR; PG8_WAIT_L(0); PG8_MMA(0, 0, At, B0); PG8_BAR; PG8_SCHED;
            PG8_LDB(B1, 0, 1); PG8_STAGE(PG8_SB(0, 0), b2, voffB);
            PG8_BAR; PG8_WAIT_L(0); PG8_MMA(0, 1, At, B1); PG8_BAR;
            PG8_LDA(At, 0, 1); PG8_STAGE(PG8_SA(0, 0), a2, voffA);
            PG8_BAR; PG8_WAIT_L(0); PG8_MMA(1, 0, At, B0); PG8_BAR; PG8_SCHED;
            PG8_STAGE(PG8_SB(0, 1), b2 + hstep, voffB);
            PG8_WAIT_V(6); PG8_BAR; PG8_MMA(1, 1, At, B1); PG8_BAR;
            PG8_LDB(B0, 1, 0); PG8_SCHED; PG8_LDA(At, 1, 0); PG8_STAGE(PG8_SA(0, 1), a2 + hstep, voffA);
            PG8_WAIT_L(8); PG8_BAR; PG8_WAIT_L(0); PG8_MMA(0, 0, At, B0); PG8_BAR; PG8_SCHED;
            PG8_LDB(B1, 1, 1); PG8_STAGE(PG8_SB(1, 0), b3, voffB);
            PG8_BAR; PG8_WAIT_L(0); PG8_MMA(0, 1, At, B1); PG8_BAR;
            PG8_LDA(At, 1, 1); PG8_STAGE(PG8_SA(1, 0), a3, voffA);
            PG8_BAR; PG8_WAIT_L(0); PG8_MMA(1, 0, At, B0); PG8_BAR; PG8_SCHED;
            PG8_STAGE(PG8_SB(1, 1), b3 + hstep, voffB);
            PG8_WAIT_V(6); PG8_BAR; PG8_MMA(1, 1, At, B1); PG8_BAR;
            }
        }
        if constexpr (ALIGN_EPI) { if (wr == 0) PG8_BAR; }
        if constexpr (!Epi::AFTER_DRAIN) { E(acc, cur, wr, wc, fr, fq); S.done(cur); }
        if (!has_next) break;
#pragma unroll
        for (int a = 0; a < 2; ++a)
#pragma unroll
            for (int b = 0; b < 2; ++b)
#pragma unroll
                for (int m = 0; m < 4; ++m)
#pragma unroll
                    for (int n = 0; n < 2; ++n) acc[a][b][m][n] = (f32x4){0.f, 0.f, 0.f, 0.f};
        cur = nxt; cA = nA; cB = nB; ++ui;
        if constexpr (ALIGN_EPI) { if (wr == 1) PG8_BAR; }
    }
    PG8_WAIT_V(0);
    if constexpr (!ALIGN_EPI) { if (wr == 0) PG8_BAR; }
    PG8_BAR;
    if constexpr (Epi::AFTER_DRAIN) { E.fused(acc, cur, wr, wc, fr, fq, lds, wid, lane); S.done(cur); }
#undef PG8_SA
#undef PG8_SB
#undef PG8_STAGE
#undef PG8_LDA
#undef PG8_LDB
#undef PG8_MMA
#undef PG8_WAIT_V
#undef PG8_WAIT_L
#undef PG8_BAR
#undef PG8_SCHED
}
}
#define GAS __attribute__((address_space(1)))
#define LAS __attribute__((address_space(3)))
typedef unsigned short bf16;
typedef unsigned v4u __attribute__((ext_vector_type(4)));
typedef float f32x4 __attribute__((ext_vector_type(4)));
typedef short bf16x8 __attribute__((ext_vector_type(8)));
typedef GAS unsigned gu32;
typedef GAS unsigned long long gu64;
#define RLX_AGENT __ATOMIC_RELAXED, __HIP_MEMORY_SCOPE_AGENT
#define LDS_WAIT() asm volatile("s_waitcnt lgkmcnt(0)" ::: "memory")
#define VM_WAIT() asm volatile("s_waitcnt vmcnt(0)" ::: "memory")
__device__ __forceinline__ unsigned long long rt() { return __builtin_amdgcn_s_memrealtime(); }
__device__ __forceinline__ unsigned f2bf(float f) { unsigned u = __builtin_bit_cast(unsigned, f); return (u + 0x7fffu + ((u >> 16) & 1u)) >> 16; }
__device__ __forceinline__ unsigned pk2(float lo, float hi) { return f2bf(lo) | (f2bf(hi) << 16); }
#define XB_TMO      128
#define XB_XCNT(j)  (256  + 64 * (j))
#define XB_XSUB(j)  (1280 + 64 * (j))
#define XB_XGEN(j)  (2304 + 64 * (j))
#define XB_TOP      3328
#define XB_TOPGEN   3392
#define XCD_BAR_WORDS 3456
#define XB_SPIN_CAP (1u << 18)

__device__ __forceinline__ unsigned xb_ld(unsigned* p)              { return __hip_atomic_load(p, __ATOMIC_RELAXED, __HIP_MEMORY_SCOPE_AGENT); }
__device__ __forceinline__ unsigned xb_add(unsigned* p, unsigned v) { return __hip_atomic_fetch_add(p, v, __ATOMIC_RELAXED, __HIP_MEMORY_SCOPE_AGENT); }
__device__ __forceinline__ unsigned xb_xcc_id() { return (unsigned)__builtin_amdgcn_s_getreg((3 << 11) | 20) & 0xFu; }
#define XB_SPIN(cond, bar) do { unsigned _sp = 0; while (cond) { __builtin_amdgcn_s_sleep(1); \
    if ((++_sp & 255u) == 0u) { if (xb_ld(&(bar)[XB_TMO])) break; if (_sp > XB_SPIN_CAP) { atomicAdd(&(bar)[XB_TMO], 1u); break; } } } } while (0)

struct XcdBarrier {
    unsigned* bar; unsigned x;
    volatile LAS unsigned* st;
};

__device__ __forceinline__ XcdBarrier xcd_barrier_post(unsigned* bar, volatile LAS unsigned* st) {
    XcdBarrier b; b.bar = bar; b.x = xb_xcc_id(); b.st = st;
    if (threadIdx.x == 0) (void)xb_add(&bar[XB_XCNT(b.x)], 1u);
    return b;
}
__device__ __forceinline__ void xcd_barrier_complete(unsigned* bar, unsigned x, unsigned& nloc, unsigned& nx) {
    const unsigned G = gridDim.x * gridDim.y * gridDim.z;
    unsigned sum, cnt, mine, sp = 0u;
    for (;;) {
        sum = 0u; cnt = 0u; mine = 0u;
#pragma unroll
        for (unsigned j = 0; j < 16; ++j) { const unsigned c = xb_ld(&bar[XB_XCNT(j)]); sum += c; cnt += (c > 0u) ? 1u : 0u; mine = (j == x) ? c : mine; }
        if (sum == G) break;
        __builtin_amdgcn_s_sleep(1);
        if ((++sp & 255u) == 0u) { if (xb_ld(&bar[XB_TMO])) break; if (sp > XB_SPIN_CAP) { atomicAdd(&bar[XB_TMO], 1u); break; } }
    }
    nloc = mine > 0u ? mine : 1u; nx = cnt > 0u ? cnt : 1u;
}

__device__ __forceinline__ void xcd_barrier(const XcdBarrier& b) {
    asm volatile("s_waitcnt vmcnt(0)" ::: "memory");
    __syncthreads();
    if (threadIdx.x == 0) {
        unsigned* bar = b.bar;
        __builtin_amdgcn_s_waitcnt(0);
        unsigned nloc = b.st[0], nx = b.st[1];
        if (nloc == 0u) { xcd_barrier_complete(bar, b.x, nloc, nx); b.st[0] = nloc; b.st[1] = nx; }
        const unsigned old = xb_add(&bar[XB_XSUB(b.x)], 1u);
        const unsigned gen = old / nloc;
        if (old + 1u == (gen + 1u) * nloc) {
            __builtin_amdgcn_fence(__ATOMIC_RELEASE, "agent");
            asm volatile("s_waitcnt vmcnt(0)" ::: "memory");
            const unsigned og = xb_add(&bar[XB_TOP], 1u);
            const unsigned tg = og / nx;
            if (og + 1u == (tg + 1u) * nx) xb_add(&bar[XB_TOPGEN], 1u);
            else XB_SPIN(xb_ld(&bar[XB_TOPGEN]) == tg, bar);
            __builtin_amdgcn_fence(__ATOMIC_ACQUIRE, "agent");
            xb_add(&bar[XB_XGEN(b.x)], 1u);
            asm volatile("s_waitcnt vmcnt(0)" ::: "memory");
        } else {
            XB_SPIN(xb_ld(&bar[XB_XGEN(b.x)]) == gen, bar);
            __builtin_amdgcn_fence(__ATOMIC_ACQUIRE, "agent");
            asm volatile("s_waitcnt vmcnt(0)" ::: "memory");
        }
    }
    __syncthreads();
}
constexpr int BATCH = 2, SEQ = 8192, D = 1024, M = BATCH * SEQ, FF = 4096, PLE = 256;
constexpr int IN_COLS = 9744;
constexpr int C_Q = 0, C_K = 512, C_V = 1024, C_R = 2048, C_A = 3072, C_ATT = 3088, C_GATE = 7696;
constexpr int N_ATT = 4608, N_GLA = 3072, N_GATE = 2048;
constexpr int NCHUNK = M / 64;
constexpr float EPS = 1e-6f;
constexpr float QSCALE = 0.08838834764831845f;
constexpr int NWAVES = 8;

constexpr size_t MiB = 1u << 20;
constexpr size_t WS_CTL = 0, CTL_ZERO_BYTES = 1 * MiB;
constexpr size_t WS_WATT = 1 * MiB, WS_WGLA = 10 * MiB, WS_WGATE = 16 * MiB, WS_WOGLA = 20 * MiB, WS_WOATT = 22 * MiB, WS_WOUT = 23 * MiB;
constexpr size_t WS_W1 = 25 * MiB, WS_W2 = 33 * MiB, WS_WPG = 41 * MiB, WS_WPP = 43 * MiB;
constexpr size_t WS_DEC = 43 * MiB + 512 * 1024;
constexpr size_t WS_RS2 = 44 * MiB;
constexpr size_t WS_RS3 = 45 * MiB;
constexpr size_t WS_LUT = 46 * MiB;
constexpr size_t WS_XN = 47 * MiB;
constexpr size_t WS_PB = 79 * MiB;
constexpr size_t WS_R = 87 * MiB;
constexpr size_t WS_QKVA = WS_R;
constexpr size_t WS_QD = WS_R, WS_KI = WS_R + 16 * MiB, WS_KO = WS_R + 32 * MiB, WS_V = WS_R + 48 * MiB, WS_RG = WS_R + 80 * MiB, WS_US = WS_R + 112 * MiB;
constexpr size_t WS_SG = WS_R, WS_UF = WS_R + 64 * MiB, WS_U = WS_R + 128 * MiB;
constexpr size_t WS_X1B = WS_R, WS_H = WS_R + 32 * MiB;
constexpr size_t WS_END = 256 * MiB;
constexpr size_t DO_BC = 0, DO_OGLA = 0, DO_OATT = 40 * MiB;
constexpr int CW_BAR = 4096;

constexpr int RING_OFF = 0, RING_BYTES = 131072;
constexpr int LDSCTL_OFF = 159744, MISC_OFF = LDSCTL_OFF + 320;
constexpr int LDS_BYTES = 160 * 1024;
namespace epi {
using pg8::f32x4; using pg8::u32x4; using pg8::Unit; using pg8::cvt_pk_bf16; using pg8::bf16_t;
constexpr int BM = 256, HALF = 128;
__device__ __forceinline__ u32x4 pack8(const f32x4& a, const f32x4& b) { u32x4 w; w.x = cvt_pk_bf16(a[0], a[1]); w.y = cvt_pk_bf16(a[2], a[3]); w.z = cvt_pk_bf16(b[0], b[1]); w.w = cvt_pk_bf16(b[2], b[3]); return w; }
__device__ __forceinline__ void unpack8(const u32x4& w, f32x4& a, f32x4& b) {
    a = (f32x4){__uint_as_float(w.x << 16), __uint_as_float(w.x & 0xffff0000u), __uint_as_float(w.y << 16), __uint_as_float(w.y & 0xffff0000u)};
    b = (f32x4){__uint_as_float(w.z << 16), __uint_as_float(w.z & 0xffff0000u), __uint_as_float(w.w << 16), __uint_as_float(w.w & 0xffff0000u)}; }
__device__ __forceinline__ f32x4 exp4(const f32x4& x) { return (f32x4){__expf(x[0]), __expf(x[1]), __expf(x[2]), __expf(x[3])}; }
__device__ __forceinline__ f32x4 sig4(const f32x4& x) { return (f32x4){1.f / (1.f + __expf(-x[0])), 1.f / (1.f + __expf(-x[1])), 1.f / (1.f + __expf(-x[2])), 1.f / (1.f + __expf(-x[3]))}; }
__device__ __forceinline__ float sum4sq(const f32x4& x) { return (x[0] * x[0] + x[1] * x[1]) + (x[2] * x[2] + x[3] * x[3]); }
__device__ __forceinline__ float row_rstd(const float* RS, int row) {
    const f32x4 a = *(const f32x4*)(RS + (size_t)row * 16), b = *(const f32x4*)(RS + (size_t)row * 16 + 4), c = *(const f32x4*)(RS + (size_t)row * 16 + 8), d = *(const f32x4*)(RS + (size_t)row * 16 + 12);
    const float ss = (((a[0] + a[1]) + (a[2] + a[3])) + ((b[0] + b[1]) + (b[2] + b[3]))) + (((c[0] + c[1]) + (c[2] + c[3])) + ((d[0] + d[1]) + (d[2] + d[3])));
    return rsqrtf(ss * (1.f / 1024.f) + EPS); }
#define EPI_LOOP_ROWS  _Pragma("unroll") for (int ai = 0; ai < 2; ++ai) _Pragma("unroll") for (int m = 0; m < 4; ++m)
#define EPI_LOOP_BJ    _Pragma("unroll") for (int bj = 0; bj < 2; ++bj)

struct EpiStore { static constexpr bool PERM = true, AFTER_DRAIN = false; bf16_t* O; int ldc;
    __device__ __forceinline__ void operator()(const f32x4 (&acc)[2][2][4][2], const Unit& u, int wr, int wc, int fr, int fq) const {
        const int row0 = u.pm * BM + wr * 64 + fr, col0 = u.pn * BM + wc * 32 + 8 * fq;
        EPI_LOOP_ROWS { bf16_t* rowp = O + (size_t)(row0 + ai * HALF + m * 16) * ldc + col0;
            EPI_LOOP_BJ *(u32x4*)(rowp + bj * HALF) = pack8(acc[ai][bj][m][0], acc[ai][bj][m][1]); } } };
struct EpiGla { static constexpr bool PERM = true, AFTER_DRAIN = false; bf16_t *QD, *KI, *KO, *V, *R; const float* BC;
    __device__ __forceinline__ void operator()(const f32x4 (&acc)[2][2][4][2], const Unit& u, int wr, int wc, int fr, int fq) const {
        const int row0 = u.pm * BM + wr * 64 + fr, cl = wc * 32 + 8 * fq;
        if (u.pn < 2) {
            EPI_LOOP_ROWS { const int row = row0 + ai * HALF + m * 16;
                EPI_LOOP_BJ { const size_t o = (size_t)row * 512 + u.pn * 256 + bj * HALF + cl;
                    const f32x4 b0 = *(const f32x4*)(BC + o), b1 = *(const f32x4*)(BC + o + 4);
                    *(u32x4*)(QD + o) = pack8(acc[ai][bj][m][0] * QSCALE * exp4(b0), acc[ai][bj][m][1] * QSCALE * exp4(b1)); } }
        } else if (u.pn < 4) {
            EPI_LOOP_ROWS { const int row = row0 + ai * HALF + m * 16;
                EPI_LOOP_BJ { const int c = (u.pn - 2) * 256 + bj * HALF + cl; const size_t o = (size_t)row * 512 + c, ol = (size_t)(row | 63) * 512 + c;
                    const f32x4 b0 = *(const f32x4*)(BC + o), b1 = *(const f32x4*)(BC + o + 4), l0 = *(const f32x4*)(BC + ol), l1 = *(const f32x4*)(BC + ol + 4);
                    *(u32x4*)(KI + o) = pack8(acc[ai][bj][m][0] * exp4(-b0), acc[ai][bj][m][1] * exp4(-b1));
                    *(u32x4*)(KO + o) = pack8(acc[ai][bj][m][0] * exp4(l0 - b0), acc[ai][bj][m][1] * exp4(l1 - b1)); } }
        } else {
            bf16_t* O = u.pn < 8 ? V : R; const int ct = (u.pn < 8 ? u.pn - 4 : u.pn - 8) * 256 + cl;
            EPI_LOOP_ROWS { bf16_t* rowp = O + (size_t)(row0 + ai * HALF + m * 16) * 1024 + ct;
                EPI_LOOP_BJ *(u32x4*)(rowp + bj * HALF) = pack8(acc[ai][bj][m][0], acc[ai][bj][m][1]); }
        } } };
struct EpiGate { static constexpr bool PERM = true, AFTER_DRAIN = false; bf16_t* SG;
    __device__ __forceinline__ void operator()(const f32x4 (&acc)[2][2][4][2], const Unit& u, int wr, int wc, int fr, int fq) const {
        const int row0 = u.pm * BM + wr * 64 + fr, col0 = (u.pn & 3) * BM + wc * 32 + 8 * fq; bf16_t* O = SG + (size_t)(u.pn >> 2) * M * 1024;
        EPI_LOOP_ROWS { bf16_t* rowp = O + (size_t)(row0 + ai * HALF + m * 16) * 1024 + col0;
            EPI_LOOP_BJ *(u32x4*)(rowp + bj * HALF) = pack8(sig4(acc[ai][bj][m][0]), sig4(acc[ai][bj][m][1])); } } };
struct EpiMulStore { static constexpr bool PERM = true, AFTER_DRAIN = false; const bf16_t* SGm; float* UF;
    __device__ __forceinline__ void operator()(const f32x4 (&acc)[2][2][4][2], const Unit& u, int wr, int wc, int fr, int fq) const {
        const int row0 = u.pm * BM + wr * 64 + fr, col0 = u.pn * BM + wc * 32 + 8 * fq;
        EPI_LOOP_ROWS { const size_t ro = (size_t)(row0 + ai * HALF + m * 16) * 1024 + col0;
            EPI_LOOP_BJ { f32x4 s0 = (f32x4){1.f, 1.f, 1.f, 1.f}, s1 = s0; if (SGm) unpack8(*(const u32x4*)(SGm + ro + bj * HALF), s0, s1);
                *(f32x4*)(UF + ro + bj * HALF) = s0 * acc[ai][bj][m][0]; *(f32x4*)(UF + ro + bj * HALF + 4) = s1 * acc[ai][bj][m][1]; } } } };
struct EpiMulAddStore { static constexpr bool PERM = true, AFTER_DRAIN = false; const bf16_t* SGm; const float* UF; bf16_t* U;
    __device__ __forceinline__ void operator()(const f32x4 (&acc)[2][2][4][2], const Unit& u, int wr, int wc, int fr, int fq) const {
        const int row0 = u.pm * BM + wr * 64 + fr, col0 = u.pn * BM + wc * 32 + 8 * fq;
        EPI_LOOP_ROWS { const size_t ro = (size_t)(row0 + ai * HALF + m * 16) * 1024 + col0;
            EPI_LOOP_BJ { f32x4 s0, s1; unpack8(*(const u32x4*)(SGm + ro + bj * HALF), s0, s1);
                const f32x4 t0 = *(const f32x4*)(UF + ro + bj * HALF), t1 = *(const f32x4*)(UF + ro + bj * HALF + 4);
                *(u32x4*)(U + ro + bj * HALF) = pack8(t0 + s0 * acc[ai][bj][m][0], t1 + s1 * acc[ai][bj][m][1]); } } } };
struct EpiResid { static constexpr bool PERM = true, AFTER_DRAIN = false; const float* xi; float* xo; bf16_t* XB; float* RS;
    __device__ __forceinline__ void operator()(const f32x4 (&acc)[2][2][4][2], const Unit& u, int wr, int wc, int fr, int fq) const {
        const int row0 = u.pm * BM + wr * 64 + fr, col0 = u.pn * BM + wc * 32 + 8 * fq;
        EPI_LOOP_ROWS { const int row = row0 + ai * HALF + m * 16; const size_t ro = (size_t)row * 1024 + col0; float ss = 0.f;
            EPI_LOOP_BJ { const f32x4 o0 = *(const f32x4*)(xi + ro + bj * HALF) + acc[ai][bj][m][0], o1 = *(const f32x4*)(xi + ro + bj * HALF + 4) + acc[ai][bj][m][1];
                *(f32x4*)(xo + ro + bj * HALF) = o0; *(f32x4*)(xo + ro + bj * HALF + 4) = o1; *(u32x4*)(XB + ro + bj * HALF) = pack8(o0, o1); ss += sum4sq(o0) + sum4sq(o1); }
            ss += __shfl_xor(ss, 16); ss += __shfl_xor(ss, 32);
            if (fq == 0) RS[(size_t)row * 16 + u.pn * 4 + wc] = ss; } } };
struct EpiMlp1 { static constexpr bool PERM = true, AFTER_DRAIN = false; const float* RS; bf16_t* H;
    __device__ __forceinline__ void operator()(const f32x4 (&acc)[2][2][4][2], const Unit& u, int wr, int wc, int fr, int fq) const {
        const int row0 = u.pm * BM + wr * 64 + fr, col0 = u.pn * BM + wc * 32 + 8 * fq;
        EPI_LOOP_ROWS { const int row = row0 + ai * HALF + m * 16; const float rstd = row_rstd(RS, row); bf16_t* rowp = H + (size_t)row * FF + col0;
            EPI_LOOP_BJ { f32x4 a = acc[ai][bj][m][0] * rstd, b = acc[ai][bj][m][1] * rstd;
                a = __builtin_elementwise_max(a, (f32x4){0.f, 0.f, 0.f, 0.f}); b = __builtin_elementwise_max(b, (f32x4){0.f, 0.f, 0.f, 0.f});
                *(u32x4*)(rowp + bj * HALF) = pack8(a * a, b * b); } } } };
struct EpiPle { static constexpr bool PERM = true, AFTER_DRAIN = false; const float* RS3; const float* T; float* x; float* RSo;
    __device__ __forceinline__ void operator()(const f32x4 (&acc)[2][2][4][2], const Unit& u, int wr, int wc, int fr, int fq) const {
        const int row0 = u.pm * BM + wr * 64 + fr, col0 = u.pn * BM + wc * 32 + 8 * fq;
        EPI_LOOP_ROWS { const int row = row0 + ai * HALF + m * 16; const float rstd = row_rstd(RS3, row); const size_t ro = (size_t)row * 1024 + col0; float ss = 0.f;
            EPI_LOOP_BJ { const f32x4 t0 = *(const f32x4*)(T + ro + bj * HALF), t1 = *(const f32x4*)(T + ro + bj * HALF + 4);
                const f32x4 o0 = *(const f32x4*)(x + ro + bj * HALF) + sig4(acc[ai][bj][m][0] * rstd) * t0, o1 = *(const f32x4*)(x + ro + bj * HALF + 4) + sig4(acc[ai][bj][m][1] * rstd) * t1;
                *(f32x4*)(x + ro + bj * HALF) = o0; *(f32x4*)(x + ro + bj * HALF + 4) = o1; ss += sum4sq(o0) + sum4sq(o1); }
            ss += __shfl_xor(ss, 16); ss += __shfl_xor(ss, 32);
            if (fq == 0) RSo[(size_t)row * 16 + u.pn * 4 + wc] = ss; } } };
struct OneUnit { Unit u;
    __device__ __forceinline__ bool next(int i, Unit& o) const { if (i) return false; o = u; return true; }
    __device__ __forceinline__ void a_ready(const Unit&) const {}
    __device__ __forceinline__ void done(const Unit&) const {} };
}
__device__ __forceinline__ float wave_sum(float v) {
#pragma unroll
    for (int o = 1; o < 64; o <<= 1) v += __shfl_xor(v, o);
    return v;
}
__device__ __forceinline__ void p0_transpose_item(const float* W, int ldw, int col0, int K, int N, const float* sc, bf16* WT, LAS float* scr, int item, int lane) {
    const int nblk = N / 32, kb = item / nblk, nb = item % nblk, k0 = 64 * kb, n0 = 32 * nb;
#pragma unroll 8
    for (int i = 0; i < 32; ++i) { const int kk = 2 * i + (lane >> 5); float v = W[(size_t)(k0 + kk) * ldw + col0 + n0 + (lane & 31)]; if (sc) v *= sc[k0 + kk]; scr[kk * 33 + (lane & 31)] = v; }
    LDS_WAIT(); asm volatile("" ::: "memory");
    const int c = lane & 7;
#pragma unroll
    for (int j = 0; j < 4; ++j) { const int n = (lane >> 3) + 8 * j; const LAS float* s = scr + (8 * c) * 33 + n;
        v4u o; o.x = pk2(s[0 * 33], s[1 * 33]); o.y = pk2(s[2 * 33], s[3 * 33]); o.z = pk2(s[4 * 33], s[5 * 33]); o.w = pk2(s[6 * 33], s[7 * 33]);
        *(GAS v4u*)(WT + (size_t)(n0 + n) * K + k0 + 8 * c) = o; }
    LDS_WAIT(); asm volatile("" ::: "memory");
}
struct Ptrs {
    const float *x, *p, *ln1, *w_in, *w_a2, *b_a, *gla_gn, *w_o_gla, *w_o_attn, *w_out, *ln2, *w_mlp1, *w_mlp2, *ln3, *w_pp, *w_pg, *rel_bias, *ln_f;
    float* out; unsigned char* ws;
};
__device__ __forceinline__ void p0_chunk(const Ptrs& P, int chunk, LAS float* ha  , int tid) {
    const int lane = tid & 63, wave = tid >> 6;
    bf16* XN = (bf16*)(P.ws + WS_XN); float* BC = (float*)((char*)P.out + DO_BC); float* DEC = (float*)(P.ws + WS_DEC);
    for (int rr = 0; rr < 8; ++rr) {
        const int r = wave * 8 + rr; const size_t row = (size_t)chunk * 64 + r;
        float ss = 0.f;
#pragma unroll
        for (int j = 0; j < 4; ++j) { const f32x4 v = *(const f32x4*)(P.x + row * D + 256 * j + 4 * lane); ss += v[0] * v[0] + v[1] * v[1] + v[2] * v[2] + v[3] * v[3]; }
        ss = wave_sum(ss); const float rstd = rsqrtf(ss * (1.f / D) + EPS);
        float acc[16];
#pragma unroll
        for (int o = 0; o < 16; ++o) acc[o] = 0.f;
#pragma unroll 1
        for (int j = 0; j < 4; ++j) {
            const int c0 = 256 * j + 4 * lane;
            const f32x4 v = *(const f32x4*)(P.x + row * D + c0); const f32x4 g = *(const f32x4*)(P.ln1 + c0);
            float h[4];
#pragma unroll
            for (int e = 0; e < 4; ++e) { h[e] = v[e] * rstd * g[e];
                const float* wr = P.w_in + (size_t)(c0 + e) * IN_COLS + C_A;
#pragma unroll
                for (int o = 0; o < 16; ++o) acc[o] += h[e] * wr[o]; }
            *(uint2*)(XN + row * D + c0) = make_uint2(pk2(h[0], h[1]), pk2(h[2], h[3]));
        }
#pragma unroll
        for (int o = 0; o < 16; ++o) { const float s = wave_sum(acc[o]); if (lane == 0) ha[r * 16 + o] = s; }
    }
    __syncthreads();
    {   const int t = tid; float w[16];
#pragma unroll
        for (int j = 0; j < 16; ++j) w[j] = P.w_a2[j * 512 + t];
        const float bb = P.b_a[t]; float cum = 0.f;
        for (int r = 0; r < 64; ++r) {
            float z = bb;
#pragma unroll
            for (int j = 0; j < 16; ++j) z += ha[r * 16 + j] * w[j];
            const float ls = fminf(z, 0.f) - log1pf(expf(-fabsf(z)));
            cum += ls * (1.f / 16.f);
            BC[((size_t)chunk * 64 + r) * 512 + t] = cum;
        }
        DEC[(size_t)chunk * 512 + t] = expf(cum);
    }
    __syncthreads();
}
__device__ __forceinline__ void p0_prologue(const Ptrs& P, LAS unsigned char* lds, int vcu, int G, int tid) {
    const int lane = tid & 63, wave = __builtin_amdgcn_readfirstlane(tid >> 6);
    LAS float* scr = (LAS float*)(lds + RING_OFF + wave * 16384);
    const int gw = vcu * NWAVES + wave, NGW = G * NWAVES;
    unsigned char* ws = P.ws;
    constexpr int I_ATT = (D / 64) * (N_ATT / 32), I_GLA = (D / 64) * (N_GLA / 32), I_GATE = (D / 64) * (N_GATE / 32), I_SQ = (D / 64) * (D / 32), I_OATT = (512 / 64) * (D / 32),
                  I_1 = (D / 64) * (FF / 32), I_2 = (FF / 64) * (D / 32), I_PP = (PLE / 64) * (D / 32);
    constexpr int NITEMS = I_ATT + I_GLA + I_GATE + 3 * I_SQ + I_OATT + I_1 + I_2 + I_PP;
    for (int it = gw; it < NITEMS; it += NGW) {
        int r = it;
        if (r < I_ATT) { p0_transpose_item(P.w_in, IN_COLS, C_ATT, D, N_ATT, nullptr, (bf16*)(ws + WS_WATT), scr, r, lane); continue; } r -= I_ATT;
        if (r < I_GLA) { p0_transpose_item(P.w_in, IN_COLS, C_Q, D, N_GLA, nullptr, (bf16*)(ws + WS_WGLA), scr, r, lane); continue; } r -= I_GLA;
        if (r < I_GATE) { p0_transpose_item(P.w_in, IN_COLS, C_GATE, D, N_GATE, nullptr, (bf16*)(ws + WS_WGATE), scr, r, lane); continue; } r -= I_GATE;
        if (r < I_SQ) { p0_transpose_item(P.w_o_gla, D, 0, D, D, nullptr, (bf16*)(ws + WS_WOGLA), scr, r, lane); continue; } r -= I_SQ;
        if (r < I_SQ) { p0_transpose_item(P.w_out, D, 0, D, D, nullptr, (bf16*)(ws + WS_WOUT), scr, r, lane); continue; } r -= I_SQ;
        if (r < I_SQ) { p0_transpose_item(P.w_pg, D, 0, D, D, P.ln3, (bf16*)(ws + WS_WPG), scr, r, lane); continue; } r -= I_SQ;
        if (r < I_OATT) { p0_transpose_item(P.w_o_attn, D, 0, 512, D, nullptr, (bf16*)(ws + WS_WOATT), scr, r, lane); continue; } r -= I_OATT;
        if (r < I_1) { p0_transpose_item(P.w_mlp1, FF, 0, D, FF, P.ln2, (bf16*)(ws + WS_W1), scr, r, lane); continue; } r -= I_1;
        if (r < I_2) { p0_transpose_item(P.w_mlp2, D, 0, FF, D, nullptr, (bf16*)(ws + WS_W2), scr, r, lane); continue; } r -= I_2;
        p0_transpose_item(P.w_pp, D, 0, PLE, D, nullptr, (bf16*)(ws + WS_WPP), scr, r, lane);
    }
    { const size_t nv = (size_t)M * PLE / 8; bf16* PB = (bf16*)(ws + WS_PB);
      for (size_t i = (size_t)vcu * 512 + tid; i < nv; i += (size_t)G * 512) { const f32x4 a = *(const f32x4*)(P.p + i * 8), b = *(const f32x4*)(P.p + i * 8 + 4);
          v4u o; o.x = pk2(a[0], a[1]); o.y = pk2(a[2], a[3]); o.z = pk2(b[0], b[1]); o.w = pk2(b[2], b[3]); *(v4u*)(PB + i * 8) = o; } }
    { const int i = vcu * 512 + tid;
      if (i < 3 * 4 * 129) { const int g = i / (4 * 129), hh = (i / 129) % 4, dl = i % 129; const int dil = g == 0 ? 1 : (g == 1 ? 4 : 16); const int n = dl * dil;
          int bucket; if (n < 16) bucket = n; else { const int l = 16 + (int)(log((double)n / 16.0) / log(128.0) * 16.0); bucket = l < 31 ? l : 31; }
          ((float*)(ws + WS_LUT))[i] = P.rel_bias[bucket * 12 + g * 4 + hh]; } }
    __syncthreads();
    for (int chunk = vcu; chunk < NCHUNK; chunk += G) p0_chunk(P, chunk, (LAS float*)(lds + RING_OFF), tid);
}
__device__ __forceinline__ float bf2f(bf16 v) { return __uint_as_float((unsigned)v << 16); }
typedef unsigned u32x4n __attribute__((ext_vector_type(4)));
__global__ void __launch_bounds__(256) k_attn(const bf16* __restrict__ QKV, const float* __restrict__ LUT, bf16* __restrict__ OATT) {
    __shared__ float Pm[4][3 * 129 + 1];
    const int lane = threadIdx.x & 63, w = threadIdx.x >> 6;
    const int task = blockIdx.x * 4 + w; const int row = task >> 2, hh = task & 3;
    const int b = row / SEQ, t = row % SEQ;
    float lg[3][3]; float mx = -1e30f;
#pragma unroll
    for (int g = 0; g < 3; ++g) {
        const int dil = g == 0 ? 1 : (g == 1 ? 4 : 16);
        const bf16* q = QKV + (size_t)row * N_ATT + g * 1536 + hh * 128;
        u32x4n qv[16];
#pragma unroll
        for (int i = 0; i < 16; ++i) qv[i] = *(const u32x4n*)(q + 8 * i);
#pragma unroll
        for (int rd = 0; rd < 3; ++rd) {
            const int dl = lane + 64 * rd; float v = -1e30f;
            if (dl <= 128 && t - dl * dil >= 0) {
                const bf16* k = QKV + (size_t)(b * SEQ + t - dl * dil) * N_ATT + g * 1536 + 512 + hh * 128;
                float s = 0.f;
#pragma unroll
                for (int i = 0; i < 16; ++i) { const u32x4n kv = *(const u32x4n*)(k + 8 * i);
#pragma unroll
                    for (int e = 0; e < 4; ++e) s += __uint_as_float(qv[i][e] << 16) * __uint_as_float(kv[e] << 16) + __uint_as_float(qv[i][e] & 0xffff0000u) * __uint_as_float(kv[e] & 0xffff0000u); }
                v = s * QSCALE + LUT[(g * 4 + hh) * 129 + dl];
            }
            lg[g][rd] = v; mx = fmaxf(mx, v);
        }
    }
#pragma unroll
    for (int o = 1; o < 64; o <<= 1) mx = fmaxf(mx, __shfl_xor(mx, o));
    float sum = 0.f;
#pragma unroll
    for (int g = 0; g < 3; ++g)
#pragma unroll
        for (int rd = 0; rd < 3; ++rd) { const int dl = lane + 64 * rd; const float p = lg[g][rd] > -1e29f ? __expf(lg[g][rd] - mx) : 0.f; sum += p; if (dl <= 128) Pm[w][g * 129 + dl] = p; }
    sum = wave_sum(sum);
    __syncthreads();
    float o0 = 0.f, o1 = 0.f;
    for (int g = 0; g < 3; ++g) {
        const int dil = g == 0 ? 1 : (g == 1 ? 4 : 16);
        for (int dl = 0; dl <= 128; ++dl) {
            if (t - dl * dil < 0) break;
            const float p = Pm[w][g * 129 + dl];
            const unsigned vv = *(const unsigned*)(QKV + (size_t)(b * SEQ + t - dl * dil) * N_ATT + g * 1536 + 1024 + hh * 128 + 2 * lane);
            o0 += p * __uint_as_float(vv << 16); o1 += p * __uint_as_float(vv & 0xffff0000u);
        }
    }
    const float inv = 1.f / sum;
    *(unsigned*)(OATT + (size_t)row * 512 + hh * 128 + 2 * lane) = pk2(o0 * inv, o1 * inv);
}
__global__ void __launch_bounds__(256) k_gla(const bf16* __restrict__ QD, const bf16* __restrict__ KI, const bf16* __restrict__ KO, const bf16* __restrict__ V,
                                             const bf16* __restrict__ R, const float* __restrict__ DEC, const float* __restrict__ gn, bf16* __restrict__ OGLA) {
    __shared__ float sq[64][129], sko[64][129], att[64][65], red[64][4];
    __shared__ float ski[64][129];
    const int tid = threadIdx.x, b = blockIdx.x >> 2, h = blockIdx.x & 3;
    float S[128];
#pragma unroll
    for (int d = 0; d < 128; ++d) S[d] = 0.f;
    for (int n = 0; n < 128; ++n) {
        const size_t row0 = (size_t)b * SEQ + n * 64;
        __syncthreads();
        for (int i = tid; i < 64 * 128; i += 256) { const int c = i >> 7, d = i & 127; const size_t o = (row0 + c) * 512 + h * 128 + d; sq[c][d] = bf2f(QD[o]); ski[c][d] = bf2f(KI[o]); sko[c][d] = bf2f(KO[o]); }
        __syncthreads();
        for (int i = tid; i < 64 * 64; i += 256) { const int c = i >> 6, s = i & 63; float a = 0.f; if (s <= c) { for (int d = 0; d < 128; ++d) a += sq[c][d] * ski[s][d]; } att[c][s] = a; }
        __syncthreads();
        float vcol[64];
#pragma unroll
        for (int s = 0; s < 64; ++s) vcol[s] = bf2f(V[(row0 + s) * 1024 + h * 256 + tid]);
        const float g = gn[h * 256 + tid];
        for (int c = 0; c < 64; ++c) {
            float o = 0.f;
#pragma unroll
            for (int d = 0; d < 128; ++d) o += sq[c][d] * S[d];
#pragma unroll
            for (int s = 0; s < 64; ++s) o += att[c][s] * vcol[s];
            const float ss = wave_sum(o * o);
            __syncthreads();
            if ((tid & 63) == 0) red[c][tid >> 6] = ss;
            __syncthreads();
            const float tot = red[c][0] + red[c][1] + red[c][2] + red[c][3];
            const float rstd = rsqrtf(tot * (1.f / 256.f) + EPS);
            const float r = bf2f(R[(row0 + c) * 1024 + h * 256 + tid]);
            const float silu = r / (1.f + __expf(-r));
            OGLA[(row0 + c) * 1024 + h * 256 + tid] = (bf16)f2bf(o * rstd * g * silu);
        }
        const float* dec = DEC + (size_t)(b * 128 + n) * 512 + h * 128;
#pragma unroll
        for (int d = 0; d < 128; ++d) { float u = 0.f;
#pragma unroll
            for (int s = 0; s < 64; ++s) u += sko[s][d] * vcol[s];
            S[d] = dec[d] * S[d] + u; }
    }
}
namespace gla {
typedef float f32x16 __attribute__((ext_vector_type(16)));
typedef short s16x4 __attribute__((ext_vector_type(4)));
typedef short v4i16_t __attribute__((ext_vector_type(4)));
typedef float f32x2_t __attribute__((ext_vector_type(2))); typedef __bf16 bf16x2_t __attribute__((ext_vector_type(2)));
typedef LAS const unsigned char* lptr;
#define MFMA32(a, b, c) __builtin_amdgcn_mfma_f32_32x32x16_bf16((a), (b), (c), 0, 0, 0)
__device__ __forceinline__ int crow(int r, int h) { return (r & 3) + 8 * (r >> 2) + 4 * h; }
__device__ __forceinline__ unsigned cvtpk(float lo, float hi) { f32x2_t v = {lo, hi}; bf16x2_t b = __builtin_convertvector(v, bf16x2_t); return __builtin_bit_cast(unsigned, b); }
__device__ __forceinline__ bf16x8 pack_step(const f32x16& x, int s) { v4u p; p.x = cvtpk(x[8 * s], x[8 * s + 1]); p.y = cvtpk(x[8 * s + 2], x[8 * s + 3]); p.z = cvtpk(x[8 * s + 4], x[8 * s + 5]); p.w = cvtpk(x[8 * s + 6], x[8 * s + 7]); return __builtin_bit_cast(bf16x8, p); }
__device__ __forceinline__ s16x4 tr4(lptr p) { return __builtin_bit_cast(s16x4, __builtin_amdgcn_ds_read_tr16_b64_v4i16((LAS v4i16_t*)p)); }
__device__ __forceinline__ bf16x8 cat8(s16x4 lo, s16x4 hi) { return (bf16x8){lo[0], lo[1], lo[2], lo[3], hi[0], hi[1], hi[2], hi[3]}; }
constexpr int ST_A = 272, ST_K = 320, ST_V = 576;
constexpr int L_QD = 0, L_KI = 64 * ST_A, L_KO = 2 * 64 * ST_A, L_V = L_KO + 64 * ST_K, L_DEC = L_V + 64 * ST_V, L_OB = L_DEC + 512;
constexpr int OB_ST = 260;
constexpr int L_END = L_OB + 64 * OB_ST * 4;
static_assert(L_END <= LDSCTL_OFF, "GLA LDS images fit below the control words");

__device__ __forceinline__ void stage128(const bf16* g, LAS unsigned char* img, int st, int tid) {
#pragma unroll
    for (int i = 0; i < 2; ++i) { const int id = tid + 512 * i, row = id >> 4, ch = id & 15; *(LAS v4u*)(img + row * st + ch * 16) = *(const v4u*)(g + (size_t)row * 512 + ch * 8); } }
__device__ __forceinline__ void stageV(const bf16* g, LAS unsigned char* img, int tid) {
#pragma unroll
    for (int i = 0; i < 4; ++i) { const int id = tid + 512 * i, row = id >> 5, ch = id & 31; *(LAS v4u*)(img + row * ST_V + ch * 16) = *(const v4u*)(g + (size_t)row * 1024 + ch * 8); } }
__device__ __forceinline__ bf16x8 trfrag(lptr img, int st, int r0, int r1, int c0, int lane) {
    const int q = (lane & 15) >> 2, p = lane & 3, blk = (lane >> 4) & 1; const int cb = (c0 + 16 * blk + 4 * p) * 2;
    return cat8(tr4(img + (r0 + q) * st + cb), tr4(img + (r1 + q) * st + cb)); }
__device__ __forceinline__ void state_update(f32x16 (&S)[4], lptr lds, int wv, int lane, bool scale) {
    const int hh = lane >> 5;
    if (scale) {
#pragma unroll
        for (int t = 0; t < 4; ++t)
#pragma unroll
            for (int g = 0; g < 4; ++g) { const f32x4 d = *(LAS const f32x4*)(lds + L_DEC + (32 * t + 8 * g + 4 * hh) * 4);
#pragma unroll
                for (int e = 0; e < 4; ++e) S[t][4 * g + e] *= d[e]; }
    }
#pragma unroll
    for (int s = 0; s < 4; ++s) {
        const bf16x8 vb = trfrag(lds + L_V, ST_V, 16 * s + 8 * hh, 16 * s + 8 * hh + 4, 32 * wv, lane);
#pragma unroll
        for (int t = 0; t < 4; ++t) { const bf16x8 ka = trfrag(lds + L_KO, ST_K, 16 * s + 8 * hh, 16 * s + 8 * hh + 4, 32 * t, lane); S[t] = MFMA32(ka, vb, S[t]); }
    }
}
__device__ __forceinline__ void load_dec(const float* DEC, int b, int n, int h, LAS unsigned char* lds, int tid) {
    if (tid < 128) *(LAS float*)(lds + L_DEC + tid * 4) = DEC[(size_t)(b * 128 + n) * 512 + h * 128 + tid]; }

__device__ __forceinline__ void phase1(const Ptrs& P, LAS unsigned char* lds, int w, int tid) {
    const int lane = tid & 63, wv = __builtin_amdgcn_readfirstlane(tid >> 6), hh = lane >> 5;
    const int bh = w >> 5, seg = w & 31, b = bh >> 2, h = bh & 3;
    const bf16* KO = (const bf16*)(P.ws + WS_KO); const bf16* V = (const bf16*)(P.ws + WS_V); const float* DEC = (const float*)(P.ws + WS_DEC); float* US = (float*)(P.ws + WS_US);
    f32x16 S[4];
#pragma unroll
    for (int t = 0; t < 4; ++t)
#pragma unroll
        for (int r = 0; r < 16; ++r) S[t][r] = 0.f;
    for (int c = 0; c < 4; ++c) {
        const int n = 4 * seg + c; const size_t row0 = (size_t)b * SEQ + (size_t)n * 64;
        stage128(KO + row0 * 512 + h * 128, lds + L_KO, ST_K, tid); stageV(V + row0 * 1024 + h * 256, lds + L_V, tid); load_dec(DEC, b, n, h, lds, tid);
        __syncthreads();
        state_update(S, lds, wv, lane, c > 0);
        __syncthreads();
    }
    float* Uo = US + ((size_t)(bh * 32 + seg) * 128) * 256 + 32 * wv + (lane & 31);
#pragma unroll
    for (int t = 0; t < 4; ++t)
#pragma unroll
        for (int r = 0; r < 16; ++r) Uo[(size_t)(32 * t + crow(r, hh)) * 256] = S[t][r];
}
__device__ __forceinline__ void phase_scan(const Ptrs& P, int w, int tid) {
    const int bh = w >> 5, b = bh >> 2, h = bh & 3, dk = (w & 31) * 4 + (tid >> 7), dv = (tid & 127) * 2;
    const float* DEC = (const float*)(P.ws + WS_DEC); float* US = (float*)(P.ws + WS_US);
    float2 u[32]; float dsg[32];
#pragma unroll
    for (int s = 0; s < 32; ++s) u[s] = *(const float2*)(US + ((size_t)(bh * 32 + s) * 128 + dk) * 256 + dv);
#pragma unroll
    for (int s = 0; s < 32; ++s) { float d = 1.f;
#pragma unroll
        for (int c = 0; c < 4; ++c) d *= DEC[(size_t)(b * 128 + 4 * s + c) * 512 + h * 128 + dk];
        dsg[s] = d; }
    float2 st = make_float2(0.f, 0.f);
#pragma unroll
    for (int s = 0; s < 32; ++s) { *(float2*)(US + ((size_t)(bh * 32 + s) * 128 + dk) * 256 + dv) = st; st.x = dsg[s] * st.x + u[s].x; st.y = dsg[s] * st.y + u[s].y; }
}
__device__ __forceinline__ void phase2(const Ptrs& P, LAS unsigned char* lds, int w, int tid) {
    const int lane = tid & 63, wv = __builtin_amdgcn_readfirstlane(tid >> 6), hh = lane >> 5, r32 = lane & 31;
    const int bh = w >> 5, seg = w & 31, b = bh >> 2, h = bh & 3;
    const bf16* QD = (const bf16*)(P.ws + WS_QD); const bf16* KI = (const bf16*)(P.ws + WS_KI); const bf16* KO = (const bf16*)(P.ws + WS_KO); const bf16* V = (const bf16*)(P.ws + WS_V);
    const bf16* RG = (const bf16*)(P.ws + WS_RG); const float* DEC = (const float*)(P.ws + WS_DEC); const float* US = (const float*)(P.ws + WS_US);
    bf16* OGLA = (bf16*)((char*)P.out + DO_OGLA);
    f32x16 S[4];
    { const float* Ui = US + ((size_t)(bh * 32 + seg) * 128) * 256 + 32 * wv + r32;
#pragma unroll
      for (int t = 0; t < 4; ++t)
#pragma unroll
          for (int r = 0; r < 16; ++r) S[t][r] = Ui[(size_t)(32 * t + crow(r, hh)) * 256]; }
    for (int c = 0; c < 4; ++c) {
        const int n = 4 * seg + c; const size_t row0 = (size_t)b * SEQ + (size_t)n * 64;
        stage128(QD + row0 * 512 + h * 128, lds + L_QD, ST_A, tid); stage128(KI + row0 * 512 + h * 128, lds + L_KI, ST_A, tid);
        stage128(KO + row0 * 512 + h * 128, lds + L_KO, ST_K, tid); stageV(V + row0 * 1024 + h * 256, lds + L_V, tid); load_dec(DEC, b, n, h, lds, tid);
        __syncthreads();
        f32x16 X00, X01, X11;
#pragma unroll
        for (int r = 0; r < 16; ++r) { X00[r] = 0.f; X01[r] = 0.f; X11[r] = 0.f; }
#pragma unroll
        for (int ks = 0; ks < 8; ++ks) {
            const int cb = (16 * ks + 8 * hh) * 2;
            const bf16x8 k0 = *(LAS const bf16x8*)(lds + L_KI + r32 * ST_A + cb), k1 = *(LAS const bf16x8*)(lds + L_KI + (32 + r32) * ST_A + cb);
            const bf16x8 q0 = *(LAS const bf16x8*)(lds + L_QD + r32 * ST_A + cb), q1 = *(LAS const bf16x8*)(lds + L_QD + (32 + r32) * ST_A + cb);
            X00 = MFMA32(k0, q0, X00); X01 = MFMA32(k0, q1, X01); X11 = MFMA32(k1, q1, X11);
        }
#pragma unroll
        for (int r = 0; r < 16; ++r) { if (crow(r, hh) > r32) { X00[r] = 0.f; X11[r] = 0.f; } }
        f32x16 O0, O1;
#pragma unroll
        for (int r = 0; r < 16; ++r) { O0[r] = 0.f; O1[r] = 0.f; }
#pragma unroll
        for (int s = 0; s < 2; ++s) {
            const bf16x8 v0 = trfrag(lds + L_V, ST_V, 16 * s + 4 * hh, 16 * s + 8 + 4 * hh, 32 * wv, lane);
            const bf16x8 v1 = trfrag(lds + L_V, ST_V, 32 + 16 * s + 4 * hh, 32 + 16 * s + 8 + 4 * hh, 32 * wv, lane);
            O0 = MFMA32(pack_step(X00, s), v0, O0); O1 = MFMA32(pack_step(X01, s), v0, O1); O1 = MFMA32(pack_step(X11, s), v1, O1);
        }
#pragma unroll
        for (int t = 0; t < 4; ++t)
#pragma unroll
            for (int s = 0; s < 2; ++s) {
                const bf16x8 sb = pack_step(S[t], s); const int cb = (32 * t + 16 * s + 4 * hh) * 2;
                const s16x4 a0 = *(LAS const s16x4*)(lds + L_QD + r32 * ST_A + cb), a1 = *(LAS const s16x4*)(lds + L_QD + r32 * ST_A + cb + 16);
                const s16x4 c0 = *(LAS const s16x4*)(lds + L_QD + (32 + r32) * ST_A + cb), c1 = *(LAS const s16x4*)(lds + L_QD + (32 + r32) * ST_A + cb + 16);
                O0 = MFMA32(cat8(a0, a1), sb, O0); O1 = MFMA32(cat8(c0, c1), sb, O1);
            }
        state_update(S, lds, wv, lane, true);
        { LAS float* ob = (LAS float*)(lds + L_OB) + 32 * wv + r32;
#pragma unroll
          for (int r = 0; r < 16; ++r) { ob[crow(r, hh) * OB_ST] = O0[r]; ob[(32 + crow(r, hh)) * OB_ST] = O1[r]; } }
        __syncthreads();
        { const int row = tid >> 3, cg = tid & 7; const LAS float* ob = (const LAS float*)(lds + L_OB) + row * OB_ST + 32 * cg;
          f32x4 o[8]; float ss = 0.f;
#pragma unroll
          for (int i = 0; i < 8; ++i) { o[i] = *(const LAS f32x4*)(ob + 4 * i); ss += (o[i][0] * o[i][0] + o[i][1] * o[i][1]) + (o[i][2] * o[i][2] + o[i][3] * o[i][3]); }
          ss += __shfl_xor(ss, 1); ss += __shfl_xor(ss, 2); ss += __shfl_xor(ss, 4);
          const float rstd = rsqrtf(ss * (1.f / 256.f) + EPS);
          const size_t go = (row0 + row) * 1024 + h * 256 + 32 * cg;
#pragma unroll
          for (int i = 0; i < 4; ++i) { const v4u rr = *(const v4u*)(RG + go + 8 * i); f32x4 r0, r1; epi::unpack8(__builtin_bit_cast(pg8::u32x4, rr), r0, r1);
              const f32x4 g0 = *(const f32x4*)(P.gla_gn + h * 256 + 32 * cg + 8 * i), g1 = *(const f32x4*)(P.gla_gn + h * 256 + 32 * cg + 8 * i + 4);
              f32x4 a, bq;
#pragma unroll
              for (int e = 0; e < 4; ++e) { a[e] = o[2 * i][e] * rstd * g0[e] * (r0[e] / (1.f + __expf(-r0[e]))); bq[e] = o[2 * i + 1][e] * rstd * g1[e] * (r1[e] / (1.f + __expf(-r1[e]))); }
              *(pg8::u32x4*)(OGLA + go + 8 * i) = epi::pack8(a, bq); } }
    }
}
#undef MFMA32
}
namespace attn {
typedef unsigned u32x2 __attribute__((ext_vector_type(2)));
using gla::s16x4; using gla::tr4; using gla::cat8; using gla::cvtpk; using gla::lptr;
#define MFMA16(a, b, c) __builtin_amdgcn_mfma_f32_16x16x32_bf16((a), (b), (c), 0, 0, 0)
constexpr int MB_ST = 272, L_MB = 0, L_ML = 256 * MB_ST, L_LUT = L_ML + 1024, L_VT = 72448, VT_ST = 288, VT_WAVE = 32 * VT_ST;
static_assert(L_LUT + 3 * 132 * 4 <= L_VT && L_VT + 8 * VT_WAVE <= LDSCTL_OFF, "attention LDS map");
constexpr float LOG2E = 1.4426950408889634f, C1 = QSCALE * LOG2E;

template <int NQ>
__device__ __forceinline__ void wave_task(const bf16* QKVb  , LAS unsigned char* lds, int g, int dil, int rho, int p0, int hh, int tl0, int tls, bool first, int wv, int lane) {
    const int i16 = lane & 15, g4 = lane >> 4;
    const bf16* Qg = QKVb + g * 1536 + hh * 128; const bf16* Kg = Qg + 512; const bf16* Vg = Qg + 1024;
    LAS unsigned char* vt = lds + L_VT + wv * VT_WAVE; const LAS float* lut = (const LAS float*)(lds + L_LUT) + g * 132;
    bf16x8 qf[NQ][4];
#pragma unroll
    for (int qt = 0; qt < NQ; ++qt) { const bf16* qp = Qg + (size_t)(rho + dil * (p0 + 16 * qt + i16)) * N_ATT + 8 * g4;
#pragma unroll
        for (int ks = 0; ks < 4; ++ks) qf[qt][ks] = *(const bf16x8*)(qp + 32 * ks); }
    f32x4 O[NQ][8]; float mrun[NQ], lrun[NQ];
#pragma unroll
    for (int qt = 0; qt < NQ; ++qt) { mrun[qt] = -1e30f; lrun[qt] = 0.f;
#pragma unroll
        for (int c = 0; c < 8; ++c) O[qt][c] = (f32x4){0.f, 0.f, 0.f, 0.f}; }
    const int wstart = p0 + 16 * NQ - 160;
    for (int j = 0; j < 5; ++j) {
        const int tile0 = wstart + 32 * j;
        if (tile0 + 31 < 0) continue;
        bf16x8 kf[2][4];
#pragma unroll
        for (int hf = 0; hf < 2; ++hf) { int kp = tile0 + 16 * hf + i16; kp = kp < 0 ? 0 : kp; const bf16* kptr = Kg + (size_t)(rho + dil * kp) * N_ATT + 8 * g4;
#pragma unroll
            for (int ks = 0; ks < 4; ++ks) kf[hf][ks] = *(const bf16x8*)(kptr + 32 * ks); }
        v4u vr[8];
#pragma unroll
        for (int i = 0; i < 8; ++i) { int kp = tile0 + 4 * i + g4; kp = kp < 0 ? 0 : kp; vr[i] = *(const v4u*)(Vg + (size_t)(rho + dil * kp) * N_ATT + 8 * i16); }
        f32x4 S[NQ][2];
#pragma unroll
        for (int qt = 0; qt < NQ; ++qt)
#pragma unroll
            for (int hf = 0; hf < 2; ++hf) { f32x4 a = (f32x4){0.f, 0.f, 0.f, 0.f};
#pragma unroll
                for (int ks = 0; ks < 4; ++ks) a = MFMA16(kf[hf][ks], qf[qt][ks], a);
                S[qt][hf] = a; }
#pragma unroll
        for (int i = 0; i < 8; ++i) *(LAS v4u*)(vt + (4 * i + g4) * VT_ST + 16 * i16) = vr[i];
        bf16x8 pf[NQ];
#pragma unroll
        for (int qt = 0; qt < NQ; ++qt) {
            const int qpos = p0 + 16 * qt + i16; float tmax = -1e30f; bool ok[2][4];
#pragma unroll
            for (int hf = 0; hf < 2; ++hf)
#pragma unroll
                for (int r = 0; r < 4; ++r) { const int kpos = tile0 + 16 * hf + 4 * g4 + r, dl = qpos - kpos; ok[hf][r] = (dl >= 0) && (dl <= 128) && (kpos >= 0);
                    const int dc = dl < 0 ? 0 : (dl > 128 ? 128 : dl); const float t = S[qt][hf][r] * C1 + lut[dc]; S[qt][hf][r] = t; tmax = ok[hf][r] ? fmaxf(tmax, t) : tmax; }
            tmax = fmaxf(tmax, __shfl_xor(tmax, 16)); tmax = fmaxf(tmax, __shfl_xor(tmax, 32));
            const float mn = fmaxf(mrun[qt], tmax), alpha = __builtin_amdgcn_exp2f(mrun[qt] - mn); mrun[qt] = mn;
            float ps = 0.f;
#pragma unroll
            for (int hf = 0; hf < 2; ++hf)
#pragma unroll
                for (int r = 0; r < 4; ++r) { const float p = ok[hf][r] ? __builtin_amdgcn_exp2f(S[qt][hf][r] - mn) : 0.f; S[qt][hf][r] = p; ps += p; }
            lrun[qt] = lrun[qt] * alpha + ps;
#pragma unroll
            for (int c = 0; c < 8; ++c) O[qt][c] *= alpha;
            v4u pw; pw.x = cvtpk(S[qt][0][0], S[qt][0][1]); pw.y = cvtpk(S[qt][0][2], S[qt][0][3]); pw.z = cvtpk(S[qt][1][0], S[qt][1][1]); pw.w = cvtpk(S[qt][1][2], S[qt][1][3]);
            pf[qt] = __builtin_bit_cast(bf16x8, pw);
        }
        { const int qq = i16 >> 2, pp = lane & 3; lptr vb = vt + (4 * g4 + qq) * VT_ST + 8 * pp;
#pragma unroll
          for (int c = 0; c < 8; ++c) { const bf16x8 vf = cat8(tr4(vb + 32 * c), tr4(vb + 16 * VT_ST + 32 * c));
#pragma unroll
              for (int qt = 0; qt < NQ; ++qt) O[qt][c] = MFMA16(vf, pf[qt], O[qt][c]); } }
    }
#pragma unroll
    for (int qt = 0; qt < NQ; ++qt) {
        float l = lrun[qt]; l += __shfl_xor(l, 16); l += __shfl_xor(l, 32);
        const float inv = 1.f / l; float lse = mrun[qt] + __builtin_amdgcn_logf(l);
        const int tl = tl0 + tls * (16 * qt + i16);
        LAS unsigned char* mrow = lds + L_MB + tl * MB_ST + 8 * g4; LAS float* mlp = (LAS float*)(lds + L_ML) + tl;
        float w2 = inv, w1 = 0.f;
        if (!first) { const float lp = *mlp; const float L = fmaxf(lp, lse); const float e1 = __builtin_amdgcn_exp2f(lp - L), e2 = __builtin_amdgcn_exp2f(lse - L); const float is = 1.f / (e1 + e2);
            w1 = e1 * is; w2 = e2 * is * inv; lse = L + __builtin_amdgcn_logf(e1 + e2); }
#pragma unroll
        for (int c = 0; c < 8; ++c) { f32x4 o = O[qt][c] * w2;
            if (!first) { const u32x2 pv = *(LAS const u32x2*)(mrow + 32 * c);
                o[0] += w1 * __uint_as_float(pv.x << 16); o[1] += w1 * __uint_as_float(pv.x & 0xffff0000u); o[2] += w1 * __uint_as_float(pv.y << 16); o[3] += w1 * __uint_as_float(pv.y & 0xffff0000u); }
            *(LAS u32x2*)(mrow + 32 * c) = (u32x2){cvtpk(o[0], o[1]), cvtpk(o[2], o[3])}; }
        if (g4 == 0) *mlp = lse;
    }
}
__device__ __forceinline__ void phase(const Ptrs& P, LAS unsigned char* lds, int unit, int tid) {
    const int lane = tid & 63, wv = __builtin_amdgcn_readfirstlane(tid >> 6);
    const int b = unit >> 7, hh = (unit >> 5) & 3, T0 = (unit & 31) * 256;
    const bf16* QKVb = (const bf16*)(P.ws + WS_QKVA) + (size_t)b * SEQ * N_ATT;
    { const float* LUT = (const float*)(P.ws + WS_LUT); if (tid < 3 * 129) { const int g = tid / 129, dl = tid % 129; ((LAS float*)(lds + L_LUT))[g * 132 + dl] = LUT[(g * 4 + hh) * 129 + dl] * LOG2E; } }
    __syncthreads();
    for (int k = 0; k < 2; ++k) { const int cls = 2 * wv + k; wave_task<1>(QKVb, lds, 2, 16, cls, T0 / 16, hh, cls, 16, true, wv, lane); }
    __syncthreads();
    { const int rho = wv & 3, half = wv >> 2; wave_task<2>(QKVb, lds, 1, 4, rho, T0 / 4 + 32 * half, hh, rho + 128 * half, 4, false, wv, lane); }
    __syncthreads();
    wave_task<2>(QKVb, lds, 0, 1, 0, T0 + 32 * wv, hh, 32 * wv, 1, false, wv, lane);
    __syncthreads();
    { bf16* OATT = (bf16*)((char*)P.out + DO_OATT) + ((size_t)b * SEQ + T0) * 512 + hh * 128;
#pragma unroll
      for (int i = 0; i < 8; ++i) { const int id = tid + 512 * i, row = id >> 4, ch = id & 15; *(v4u*)(OATT + (size_t)row * 512 + ch * 8) = *(LAS const v4u*)(lds + L_MB + row * MB_ST + ch * 16); } }
    __syncthreads();
}
#undef MFMA16
}
#define PHASE_ATTN attn::phase(P, lds, vcu, tid);
#define PHASE_GLA1 gla::phase1(P, lds, bx, tid);
#define PHASE_GLA_SCAN gla::phase_scan(P, bx, tid);
#define PHASE_GLA2 gla::phase2(P, lds, bx, tid);
#define LAUNCH_PLAN launch_mega(P, 0, N_PHASES, 0, grid, stream);
struct Args { Ptrs P; int ph_lo, ph_hi, li, pad; };
constexpr int N_PHASES = 13;
__global__ void __launch_bounds__(NWAVES * 64, 2) mega(Args args) {
    extern __shared__ __attribute__((aligned(16))) unsigned char lds_raw[];
    LAS unsigned char* lds = (LAS unsigned char*)lds_raw;
    const Ptrs& P = args.P;
    const int tid = threadIdx.x, lane = tid & 63, wave = __builtin_amdgcn_readfirstlane(tid >> 6);
    const int G = gridDim.x; const int bx = blockIdx.x; const int vcu = (G % 8 == 0) ? (bx % 8) * (G / 8) + bx / 8 : bx;
    unsigned char* ws = P.ws; gu32* ctl = (gu32*)(ws + WS_CTL);
    volatile LAS unsigned* MISC = (volatile LAS unsigned*)(lds + MISC_OFF);
    for (int u = tid; u < (LDS_BYTES - LDSCTL_OFF) / 4; u += NWAVES * 64) ((LAS unsigned*)(lds + LDSCTL_OFF))[u] = 0u;
    __syncthreads();
    const int lo = args.ph_lo, hi = args.ph_hi;
    XcdBarrier bar; bar.bar = (unsigned*)(ctl + CW_BAR) + args.li * XCD_BAR_WORDS; bar.x = 0; bar.st = nullptr;
    if (hi - lo > 1) bar = xcd_barrier_post((unsigned*)(ctl + CW_BAR) + args.li * XCD_BAR_WORDS, MISC + 8);
#define IN(k) (lo <= (k) && (k) < hi)
#define SEAM(k) do { if (IN(k) && IN((k) + 1)) xcd_barrier(bar); } while (0)
    bf16* XN = (bf16*)(ws + WS_XN);
    float* RS2 = (float*)(ws + WS_RS2); float* RS3 = (float*)(ws + WS_RS3);
    pg8::Unit my; { pg8::StaticOrder S; S.init(M, D, G, bx); if (!S.next(0, my)) { my.pm = 0; my.pn = 0; } }

    if (IN(0)) { p0_prologue(P, lds, vcu, G, tid); } SEAM(0);
    if (IN(1)) { pg8::Gemm g{XN, (const bf16*)(ws + WS_WATT), M, N_ATT, D}; pg8::StaticOrder S; S.init(M, N_ATT, G, bx);
        epi::EpiStore E{(bf16*)(ws + WS_QKVA), N_ATT};
        pg8::gemm_phase<epi::EpiStore, pg8::StaticOrder, true, true>(lds + RING_OFF, g, S, E); } SEAM(1);
    if (IN(2)) { PHASE_ATTN } SEAM(2);
    if (IN(3)) { pg8::Gemm g{XN, (const bf16*)(ws + WS_WGLA), M, N_GLA, D}; pg8::StaticOrder S; S.init(M, N_GLA, G, bx);
        epi::EpiGla E{(bf16*)(ws + WS_QD), (bf16*)(ws + WS_KI), (bf16*)(ws + WS_KO), (bf16*)(ws + WS_V), (bf16*)(ws + WS_RG), (const float*)((char*)P.out + DO_BC)};
        pg8::gemm_phase<epi::EpiGla, pg8::StaticOrder, true, true>(lds + RING_OFF, g, S, E); } SEAM(3);
    if (IN(4)) { PHASE_GLA1 } SEAM(4);
    if (IN(5)) { PHASE_GLA_SCAN } SEAM(5);
    if (IN(6)) { PHASE_GLA2 } SEAM(6);
    if (IN(7)) {
        const bf16* SG = (const bf16*)(ws + WS_SG); float* UF = (float*)(ws + WS_UF);
        { pg8::Gemm g{XN, (const bf16*)(ws + WS_WGATE), M, N_GATE, D}; epi::OneUnit S{{my.pm, my.pn}}; epi::EpiGate E{(bf16*)(ws + WS_SG)};
          pg8::gemm_phase<epi::EpiGate, epi::OneUnit, false, true>(lds + RING_OFF, g, S, E); }
        { pg8::Gemm g{XN, (const bf16*)(ws + WS_WGATE), M, N_GATE, D}; epi::OneUnit S{{my.pm, 4 + my.pn}}; epi::EpiGate E{(bf16*)(ws + WS_SG)};
          pg8::gemm_phase<epi::EpiGate, epi::OneUnit, false, true>(lds + RING_OFF, g, S, E); }
        { pg8::Gemm g{(const bf16*)((char*)P.out + DO_OATT), (const bf16*)(ws + WS_WOATT), M, D, 512}; epi::OneUnit S{my}; epi::EpiMulStore E{SG + (size_t)M * 1024, UF};
          pg8::gemm_phase<epi::EpiMulStore, epi::OneUnit, false, true>(lds + RING_OFF, g, S, E); }
        { pg8::Gemm g{(const bf16*)((char*)P.out + DO_OGLA), (const bf16*)(ws + WS_WOGLA), M, D, D}; epi::OneUnit S{my}; epi::EpiMulAddStore E{SG, UF, (bf16*)(ws + WS_U)};
          pg8::gemm_phase<epi::EpiMulAddStore, epi::OneUnit, false, true>(lds + RING_OFF, g, S, E); }
    } SEAM(7);
    if (IN(8)) { pg8::Gemm g{(const bf16*)(ws + WS_U), (const bf16*)(ws + WS_WOUT), M, D, D}; epi::OneUnit S{my};
        epi::EpiResid E{P.x, P.out, (bf16*)(ws + WS_X1B), RS2};
        pg8::gemm_phase<epi::EpiResid, epi::OneUnit, false, true>(lds + RING_OFF, g, S, E); } SEAM(8);
    if (IN(9)) { pg8::Gemm g{(const bf16*)(ws + WS_X1B), (const bf16*)(ws + WS_W1), M, FF, D}; pg8::StaticOrder S; S.init(M, FF, G, bx);
        epi::EpiMlp1 E{RS2, (bf16*)(ws + WS_H)};
        pg8::gemm_phase<epi::EpiMlp1, pg8::StaticOrder, true, true>(lds + RING_OFF, g, S, E); } SEAM(9);
    if (IN(10)) { pg8::Gemm g{(const bf16*)(ws + WS_H), (const bf16*)(ws + WS_W2), M, D, FF}; epi::OneUnit S{my};
        epi::EpiResid E{P.out, P.out, (bf16*)(ws + WS_X1B), RS3};
        pg8::gemm_phase<epi::EpiResid, epi::OneUnit, false, true>(lds + RING_OFF, g, S, E); } SEAM(10);
    if (IN(11)) {
        float* UF = (float*)(ws + WS_UF);
        { pg8::Gemm g{(const bf16*)(ws + WS_PB), (const bf16*)(ws + WS_WPP), M, D, PLE}; epi::OneUnit S{my}; epi::EpiMulStore E{nullptr, UF};
          pg8::gemm_phase<epi::EpiMulStore, epi::OneUnit, false, true>(lds + RING_OFF, g, S, E); }
        { pg8::Gemm g{(const bf16*)(ws + WS_X1B), (const bf16*)(ws + WS_WPG), M, D, D}; epi::OneUnit S{my}; epi::EpiPle E{RS3, UF, P.out, RS2};
          pg8::gemm_phase<epi::EpiPle, epi::OneUnit, false, true>(lds + RING_OFF, g, S, E); }
    } SEAM(11);
    if (IN(12)) {
        for (int row = vcu * NWAVES + wave; row < M; row += G * NWAVES) { const float rstd = epi::row_rstd(RS2, row);
#pragma unroll
            for (int j = 0; j < 4; ++j) { float* o = P.out + (size_t)row * D + 256 * j + 4 * lane; *(f32x4*)o = *(const f32x4*)o * rstd * *(const f32x4*)(P.ln_f + 256 * j + 4 * lane); } }
    }
#undef IN
#undef SEAM
}
static void launch_mega(const Ptrs& P, int lo, int hi, int li, int grid, hipStream_t stream) {
    Args a{}; a.P = P; a.ph_lo = lo; a.ph_hi = hi; a.li = li; a.pad = 0;
    hipLaunchKernelGGL(mega, dim3(grid), dim3(NWAVES * 64), LDS_BYTES, stream, a);
}
extern "C" void kernel_launch(void* const* d_in, const int* in_sizes, int n_in, void* d_out, int out_size, void* d_ws, size_t ws_size, hipStream_t stream) {
    static int grid = 0;
    if (grid == 0) {
        if (n_in != 18 || ws_size < WS_END || out_size != M * D) { fprintf(stderr, "kernel_launch: unexpected shapes (n_in %d ws %zu out %d)\n", n_in, ws_size, out_size); grid = -1; return; }
        int dev = 0, cus = 0;
        if (hipGetDevice(&dev) != hipSuccess || hipDeviceGetAttribute(&cus, hipDeviceAttributeMultiprocessorCount, dev) != hipSuccess) { grid = -1; return; }
        if (hipFuncSetAttribute((const void*)mega, hipFuncAttributeMaxDynamicSharedMemorySize, LDS_BYTES) != hipSuccess) { fprintf(stderr, "kernel_launch: hipFuncSetAttribute failed\n"); grid = -1; return; }
        int per_cu = 0; (void)hipOccupancyMaxActiveBlocksPerMultiprocessor(&per_cu, (const void*)mega, NWAVES * 64, LDS_BYTES); (void)hipGetLastError();
        if (per_cu < 1) fprintf(stderr, "kernel_launch: occupancy query says %d blocks per CU\n", per_cu);
        grid = cus;
        if (grid != 256) fprintf(stderr, "kernel_launch: %d CUs; this kernel is laid out for 256\n", grid);
    }
    if (grid < 0) return;
    Ptrs P{};
    const float** pp = (const float**)&P;
    for (int i = 0; i < 18; ++i) pp[i] = (const float*)d_in[i];
    P.out = (float*)d_out; P.ws = (unsigned char*)d_ws;
    (void)hipMemsetAsync((char*)d_ws + WS_CTL, 0, CTL_ZERO_BYTES, stream);
    LAUNCH_PLAN
}
```
